# Optimizing an MI355X kernel written in HIP

```python
import jax, jax.numpy as jnp
from jax import lax
import numpy as np

D_MODEL = 1024
BATCH = 8
SEQ = 4096
DEPTH = 1

D_MIX = D_MODEL
ATTN_HEAD_DIM = 64
ATTN_HEADS = (D_MIX // 2) // ATTN_HEAD_DIM
ATTN_KV_HEADS = 2
ATTN_WIDTH = ATTN_HEADS * ATTN_HEAD_DIM
ATTN_KV_WIDTH = ATTN_KV_HEADS * ATTN_HEAD_DIM
WINDOW = 128
BLOCK = 128
ROPE_THETA = 10000.0

GLA_HEADS = 4
GLA_WIDTH = D_MIX - ATTN_WIDTH
GLA_DV = GLA_WIDTH // GLA_HEADS
GLA_DK = GLA_DV // 2
GLA_QK_WIDTH = GLA_HEADS * GLA_DK
GLA_GATE_RANK = 16
GLA_GATE_TAU = 16.0
GLA_CHUNK = 64

D_FF = 2816
PLE_DIM = 256
EPS = 1e-6

IN_SIZES = (ATTN_WIDTH, ATTN_KV_WIDTH, ATTN_KV_WIDTH,
            GLA_QK_WIDTH, GLA_QK_WIDTH, GLA_WIDTH, GLA_GATE_RANK, GLA_WIDTH)
D_IN = sum(IN_SIZES)

kernel_name = "hymba_swa_sink_gla_macaron_ple"


def rmsnorm(x, g):
    xf = x.astype(jnp.float32)
    y = xf * lax.rsqrt(jnp.mean(xf * xf, axis=-1, keepdims=True) + EPS)
    return (y * g.astype(jnp.float32)).astype(x.dtype)


def swiglu(x, w_gate, w_up, w_down):
    return (jax.nn.silu(x @ w_gate) * (x @ w_up)) @ w_down


def rope(x, pos):
    dh = x.shape[-1]
    inv_freq = ROPE_THETA ** (-jnp.arange(0, dh, 2, dtype=jnp.float32) / dh)
    ang = pos.astype(jnp.float32)[:, None] * inv_freq[None, :]
    cos = jnp.cos(ang)[None, :, None, :]
    sin = jnp.sin(ang)[None, :, None, :]
    xf = x.astype(jnp.float32)
    x1, x2 = xf[..., : dh // 2], xf[..., dh // 2:]
    out = jnp.concatenate([x1 * cos - x2 * sin, x2 * cos + x1 * sin], axis=-1)
    return out.astype(x.dtype)


def split_cols(z):
    points = np.cumsum(IN_SIZES)[:-1].tolist()
    return jnp.split(z, points, axis=-1)


def sliding_window_attention(q, k, v, sinks):
    B, S, H, Dh = q.shape
    KVH = k.shape[2]
    G = H // KVH
    NB = S // BLOCK
    qb = q.reshape(B, NB, BLOCK, KVH, G, Dh)

    def band(t):
        tb = t.reshape(B, NB, BLOCK, KVH, Dh)
        prev = jnp.pad(tb[:, :-1], ((0, 0), (1, 0), (0, 0), (0, 0), (0, 0)))
        return jnp.concatenate([prev, tb], axis=2)

    kb, vb = band(k), band(v)
    scores = jnp.einsum('bnqhgd,bnkhd->bnhgqk', qb, kb).astype(jnp.float32) * (Dh ** -0.5)
    qi = jnp.arange(BLOCK)[:, None]
    kj = jnp.arange(2 * BLOCK)[None, :]
    rel = kj - BLOCK - qi
    in_band = (rel <= 0) & (rel > -WINDOW)
    kpos = jnp.arange(NB)[:, None, None] * BLOCK + kj[None] - BLOCK
    valid = in_band[None] & (kpos >= 0)
    scores = jnp.where(valid[None, :, None, None], scores, -jnp.inf)
    sink = sinks.astype(jnp.float32).reshape(KVH, G)[None, None, :, :, None, None]
    m = jnp.maximum(jnp.max(scores, axis=-1, keepdims=True), sink)
    e = jnp.exp(scores - m)
    denom = jnp.sum(e, axis=-1, keepdims=True) + jnp.exp(sink - m)
    probs = (e / denom).astype(v.dtype)
    out = jnp.einsum('bnhgqk,bnkhd->bnqhgd', probs, vb)
    return out.reshape(B, S, H * Dh)


def gla_chunked(q, k, v, log_alpha):
    B, S, H, DK = q.shape
    DV = v.shape[-1]
    C = GLA_CHUNK
    NC = S // C

    def chunks(t):
        return t.astype(jnp.float32).reshape(B, NC, C, H, t.shape[-1]).transpose(1, 0, 3, 2, 4)

    qc = chunks(q) * (DK ** -0.5)
    kc, vc, gc = chunks(k), chunks(v), chunks(log_alpha)
    causal = jnp.tril(jnp.ones((C, C), dtype=bool))[None, None, :, :, None]

    def step(state, inp):
        qi, ki, vi, gi = inp
        b = jnp.cumsum(gi, axis=2)
        b_last = b[:, :, -1:, :]
        diff = b[:, :, :, None, :] - b[:, :, None, :, :]
        decay = jnp.exp(jnp.where(causal, diff, -jnp.inf))
        attn = jnp.einsum('bhid,bhjd,bhijd->bhij', qi, ki, decay)
        o = (jnp.einsum('bhij,bhjv->bhiv', attn, vi)
             + jnp.einsum('bhid,bhdv->bhiv', qi * jnp.exp(b), state))
        new_state = (jnp.swapaxes(jnp.exp(b_last), 2, 3) * state
                     + jnp.einsum('bhjd,bhjv->bhdv', ki * jnp.exp(b_last - b), vi))
        return new_state, o

    s0 = jnp.zeros((B, H, DK, DV), jnp.float32)
    _, o = lax.scan(step, s0, (qc, kc, vc, gc))
    return o.transpose(1, 0, 3, 2, 4).reshape(B, S, H, DV).astype(v.dtype)


def setup_inputs(seed: int = 0) -> dict:
    key = jax.random.key(seed)
    ks = jax.random.split(key, 24)
    L, D, F = DEPTH, D_MODEL, D_FF

    def w(k, shape, fan_in):
        return jax.random.normal(k, shape, jnp.float32) * (fan_in ** -0.5)

    def gain(k, shape):
        return 1.0 + 0.05 * jax.random.normal(k, shape, jnp.float32)

    return {
        "x": jax.random.normal(ks[0], (BATCH, SEQ, D), jnp.float32),
        "p": jax.random.normal(ks[1], (L, BATCH, SEQ, PLE_DIM), jnp.float32),
        "ffn1_norm": gain(ks[2], (L, D)),
        "ffn1_w_gate": w(ks[3], (L, D, F), D),
        "ffn1_w_up": w(ks[4], (L, D, F), D),
        "ffn1_w_down": w(ks[5], (L, F, D), F),
        "mix_norm": gain(ks[6], (L, D)),
        "w_in": w(ks[7], (L, D, D_IN), D),
        "q_norm": gain(ks[8], (L, ATTN_HEAD_DIM)),
        "k_norm": gain(ks[9], (L, ATTN_HEAD_DIM)),
        "attn_sinks": 0.5 * jax.random.normal(ks[10], (L, ATTN_HEADS), jnp.float32),
        "gla_w_gate_up": w(ks[11], (L, GLA_GATE_RANK, GLA_QK_WIDTH), GLA_GATE_RANK),
        "gla_b_gate": 0.1 * jax.random.normal(ks[12], (L, GLA_QK_WIDTH), jnp.float32),
        "gla_out_norm": gain(ks[13], (L, GLA_DV)),
        "w_out": w(ks[14], (L, D_MIX, D), D_MIX),
        "ffn2_norm": gain(ks[15], (L, D)),
        "ffn2_w_gate": w(ks[16], (L, D, F), D),
        "ffn2_w_up": w(ks[17], (L, D, F), D),
        "ffn2_w_down": w(ks[18], (L, F, D), F),
        "ple_gate_norm": gain(ks[19], (L, D)),
        "ple_w_gate": w(ks[20], (L, D, D), D),
        "ple_w_proj": w(ks[21], (L, PLE_DIM, D), PLE_DIM),
        "ple_norm": gain(ks[22], (L, D)),
    }


def reference(x, p, ffn1_norm, ffn1_w_gate, ffn1_w_up, ffn1_w_down, mix_norm, w_in,
              q_norm, k_norm, attn_sinks, gla_w_gate_up, gla_b_gate, gla_out_norm, w_out,
              ffn2_norm, ffn2_w_gate, ffn2_w_up, ffn2_w_down,
              ple_gate_norm, ple_w_gate, ple_w_proj, ple_norm):
    B, S, _ = x.shape
    pos = jnp.arange(S)
    h = x
    for i in range(DEPTH):
        h = h + 0.5 * swiglu(rmsnorm(h, ffn1_norm[i]), ffn1_w_gate[i], ffn1_w_up[i], ffn1_w_down[i])

        n = rmsnorm(h, mix_norm[i])
        aq, ak, av, gq, gk, gv, glr, gog = split_cols(n @ w_in[i])

        aq = rope(rmsnorm(aq.reshape(B, S, ATTN_HEADS, ATTN_HEAD_DIM), q_norm[i]), pos)
        ak = rope(rmsnorm(ak.reshape(B, S, ATTN_KV_HEADS, ATTN_HEAD_DIM), k_norm[i]), pos)
        av = av.reshape(B, S, ATTN_KV_HEADS, ATTN_HEAD_DIM)
        attn_o = sliding_window_attention(aq, ak, av, attn_sinks[i])

        log_alpha = jax.nn.log_sigmoid(
            (glr @ gla_w_gate_up[i] + gla_b_gate[i]).astype(jnp.float32)) / GLA_GATE_TAU
        gla_o = gla_chunked(gq.reshape(B, S, GLA_HEADS, GLA_DK),
                            gk.reshape(B, S, GLA_HEADS, GLA_DK),
                            gv.reshape(B, S, GLA_HEADS, GLA_DV),
                            log_alpha.reshape(B, S, GLA_HEADS, GLA_DK))
        gla_o = rmsnorm(gla_o, gla_out_norm[i]) * jax.nn.silu(gog.reshape(B, S, GLA_HEADS, GLA_DV))
        gla_o = gla_o.reshape(B, S, GLA_WIDTH)

        h = h + jnp.concatenate([attn_o, gla_o], axis=-1) @ w_out[i]

        h = h + 0.5 * swiglu(rmsnorm(h, ffn2_norm[i]), ffn2_w_gate[i], ffn2_w_up[i], ffn2_w_down[i])

        gate = jax.nn.sigmoid(rmsnorm(h, ple_gate_norm[i]) @ ple_w_gate[i])
        emb = rmsnorm(p[i] @ ple_w_proj[i], ple_norm[i])
        h = h + gate * emb
    return h
```

```cpp
#include <hip/hip_runtime.h>
#include <cstdio>
#include <cstdint>
namespace pg8 {
#define PG8_LAS __attribute__((address_space(3)))
typedef unsigned short bf16_t;
typedef short bf16x8 __attribute__((ext_vector_type(8)));
typedef float f32x4 __attribute__((ext_vector_type(4)));
typedef unsigned u32x4 __attribute__((ext_vector_type(4)));
constexpr int BM = 256, BK = 64, HALF = 128, HTB = HALF * BK * 2  , STAGE_BYTES = 8 * HTB, NXCD = 8, WGM = 8;

__host__ __device__ __forceinline__ int lds_byte(int r, int c) { const int st = (r >> 4) * 2 + (c >> 5), rr = r & 15, cc = c & 31, ob = rr * 64 + cc * 2; return st * 1024 + (ob ^ (((ob >> 9) & 1) << 5)); }
__host__ __device__ __forceinline__ void stage_rc(int b, int& R, int& C) { const int st = b / 1024, sb = b % 1024, swz = sb ^ (((sb >> 9) & 1) << 5); R = (st >> 1) * 16 + swz / 64; C = (st & 1) * 32 + (swz % 64) / 2; }
__host__ __device__ __forceinline__ int perm32(int rho) { const int n = rho >> 4, i = rho & 15; return 8 * (i >> 2) + 4 * n + (i & 3); }

struct Unit { int pm, pn; };
struct Gemm { const bf16_t* A; const bf16_t* Bt; int M, N, K; };

struct StaticOrder {
    int nM, nN, nwg, G, c;
    __host__ __device__ void init(int M, int N, int G_, int c_) { nM = M / BM; nN = N / BM; nwg = nM * nN; G = G_; c = c_; }
    __host__ __device__ bool next(int i, Unit& u) const {
        const long L = (long)i * G + c; if (L >= nwg) return false;
        int wgid = (int)L; { const int q = nwg / NXCD, r = nwg % NXCD, xcd = wgid % NXCD, off = wgid / NXCD; wgid = (xcd < r ? xcd * (q + 1) : r * (q + 1) + (xcd - r) * q) + off; }
        const int nig = WGM * nN, gid = wgid / nig, fm = gid * WGM, gsz = (nM - fm) < WGM ? (nM - fm) : WGM;
        u.pm = fm + ((wgid % nig) % gsz); u.pn = (wgid % nig) / gsz; return true;
    }
    __device__ __forceinline__ void a_ready(const Unit&) const {}
    __device__ __forceinline__ void done(const Unit&) const {}
};
__device__ __forceinline__ unsigned cvt_pk_bf16(float lo, float hi) { unsigned r; asm volatile("v_cvt_pk_bf16_f32 %0, %1, %2" : "=v"(r) : "v"(lo), "v"(hi)); return r; }
typedef float f32x2 __attribute__((ext_vector_type(2)));
constexpr float RMS_EPS = 1e-6f;
__device__ __forceinline__ float ssq16(const float* ssq, int row) {
    const f32x4* p = (const f32x4*)(ssq + (size_t)row * 16); const f32x4 a = p[0], b = p[1], c = p[2], d = p[3];
    return (((a[0] + a[1]) + (a[2] + a[3])) + ((b[0] + b[1]) + (b[2] + b[3]))) + (((c[0] + c[1]) + (c[2] + c[3])) + ((d[0] + d[1]) + (d[2] + d[3])));
}
__device__ __forceinline__ float rstd_row(const float* ssq, int row, float inv_n) { return __builtin_amdgcn_rsqf(ssq16(ssq, row) * inv_n + RMS_EPS); }
__device__ __forceinline__ float silu_f(float x) { return x * __builtin_amdgcn_rcpf(1.0f + __builtin_amdgcn_exp2f(-1.4426950408889634f * x)); }
__device__ __forceinline__ float sigmoid_f(float x) { return __builtin_amdgcn_rcpf(1.0f + __builtin_amdgcn_exp2f(-1.4426950408889634f * x)); }
__device__ __forceinline__ u32x4 pack8(const f32x4 a, const f32x4 b) { u32x4 w; w.x = cvt_pk_bf16(a[0], a[1]); w.y = cvt_pk_bf16(a[2], a[3]); w.z = cvt_pk_bf16(b[0], b[1]); w.w = cvt_pk_bf16(b[2], b[3]); return w; }
__device__ __forceinline__ float sq4(const f32x4 a) { return (a[0] * a[0] + a[1] * a[1]) + (a[2] * a[2] + a[3] * a[3]); }

struct EpiSwiGLU {
    static constexpr bool PERM = true, AFTER_DRAIN = false;
    bf16_t* O; int ldo; const float* ssq;
    __device__ __forceinline__ void operator()(const f32x4 (&acc)[2][2][4][2], const Unit& u, int wr, int wc, int fr, int fq) const {
        const int row0 = u.pm * BM + wr * 64 + fr, col0 = u.pn * HALF + wc * 32 + 8 * fq;
#pragma unroll
        for (int ai = 0; ai < 2; ++ai)
#pragma unroll
            for (int m = 0; m < 4; ++m) { const int row = row0 + ai * HALF + m * 16; const float r = rstd_row(ssq, row, 1.0f / 1024.0f);
                f32x4 o[2];
#pragma unroll
                for (int n = 0; n < 2; ++n) { const f32x4 g = acc[ai][0][m][n] * r, up = acc[ai][1][m][n] * r;
#pragma unroll
                    for (int j = 0; j < 4; ++j) o[n][j] = silu_f(g[j]) * up[j]; }
                *(u32x4*)(O + (size_t)row * ldo + col0) = pack8(o[0], o[1]); }
    }
};
struct EpiResid {
    static constexpr bool PERM = true, AFTER_DRAIN = false;
    const float* base; float* out; bf16_t* xb; float* ssq; float scale;
    __device__ __forceinline__ void operator()(const f32x4 (&acc)[2][2][4][2], const Unit& u, int wr, int wc, int fr, int fq) const {
        const int row0 = u.pm * BM + wr * 64 + fr, col0 = u.pn * BM + wc * 32 + 8 * fq;
#pragma unroll
        for (int ai = 0; ai < 2; ++ai)
#pragma unroll
            for (int m = 0; m < 4; ++m) { const int row = row0 + ai * HALF + m * 16; const size_t off = (size_t)row * 1024 + col0; float s = 0.f;
#pragma unroll
                for (int bj = 0; bj < 2; ++bj) { const f32x4 b0 = *(const f32x4*)(base + off + bj * HALF), b1 = *(const f32x4*)(base + off + bj * HALF + 4);
                    const f32x4 h0 = b0 + acc[ai][bj][m][0] * scale, h1 = b1 + acc[ai][bj][m][1] * scale;
                    *(f32x4*)(out + off + bj * HALF) = h0; *(f32x4*)(out + off + bj * HALF + 4) = h1;
                    *(u32x4*)(xb + off + bj * HALF) = pack8(h0, h1); s += sq4(h0) + sq4(h1); }
                s += __shfl_xor(s, 16); s += __shfl_xor(s, 32);
                if (fq == 0) ssq[(size_t)row * 16 + u.pn * 4 + wc] = s;
                if (m & 1) asm volatile("" ::: "memory"); }
    }
};
struct EpiZ {
    static constexpr bool PERM = true, AFTER_DRAIN = false;
    bf16_t* Z; const float* ssq; const float* cosT; const float* sinT; const float* qn; const float* kn;
    __device__ __forceinline__ void operator()(const f32x4 (&acc)[2][2][4][2], const Unit& u, int wr, int wc, int fr, int fq) const {
        const int row0 = u.pm * BM + wr * 64 + fr, col0 = u.pn * BM + wc * 64 + 8 * fq;
        const bool rope = (u.pn < 2) || (u.pn == 2 && wc < 2);
        const float osc = (u.pn < 2 || u.pn == 3) ? 0.125f : 1.0f;
        const float* gn = (u.pn < 2) ? qn : kn;
        f32x4 gl0 = {1.f, 1.f, 1.f, 1.f}, gl1 = gl0, gh0 = gl0, gh1 = gl0;
        if (rope) { gl0 = *(const f32x4*)(gn + 8 * fq); gl1 = *(const f32x4*)(gn + 8 * fq + 4); gh0 = *(const f32x4*)(gn + 32 + 8 * fq); gh1 = *(const f32x4*)(gn + 32 + 8 * fq + 4); }
#pragma unroll
        for (int ai = 0; ai < 2; ++ai)
#pragma unroll
            for (int m = 0; m < 4; ++m) { const int row = row0 + ai * HALF + m * 16; const float r1 = rstd_row(ssq, row, 1.0f / 1024.0f);
                f32x4 lo0 = acc[ai][0][m][0] * r1, lo1 = acc[ai][0][m][1] * r1, hi0 = acc[ai][1][m][0] * r1, hi1 = acc[ai][1][m][1] * r1;
                if (rope) {
                    float ss = (sq4(lo0) + sq4(lo1)) + (sq4(hi0) + sq4(hi1)); ss += __shfl_xor(ss, 16); ss += __shfl_xor(ss, 32);
                    const float rn = __builtin_amdgcn_rsqf(ss * (1.0f / 64.0f) + RMS_EPS);
                    lo0 = lo0 * rn * gl0; lo1 = lo1 * rn * gl1; hi0 = hi0 * rn * gh0; hi1 = hi1 * rn * gh1;
                    const int pos = row & 4095;
                    const f32x4 c0 = *(const f32x4*)(cosT + pos * 32 + 8 * fq), c1 = *(const f32x4*)(cosT + pos * 32 + 8 * fq + 4);
                    const f32x4 s0 = *(const f32x4*)(sinT + pos * 32 + 8 * fq), s1 = *(const f32x4*)(sinT + pos * 32 + 8 * fq + 4);
                    const f32x4 nl0 = lo0 * c0 - hi0 * s0, nl1 = lo1 * c1 - hi1 * s1, nh0 = hi0 * c0 + lo0 * s0, nh1 = hi1 * c1 + lo1 * s1;
                    lo0 = nl0; lo1 = nl1; hi0 = nh0; hi1 = nh1;
                }
                lo0 = lo0 * osc; lo1 = lo1 * osc; hi0 = hi0 * osc; hi1 = hi1 * osc;
                bf16_t* zp = Z + (size_t)row * 2560 + col0;
                *(u32x4*)(zp) = pack8(lo0, lo1); *(u32x4*)(zp + 32) = pack8(hi0, hi1); }
    }
};
struct EpiEmb {
    static constexpr bool PERM = true, AFTER_DRAIN = false;
    bf16_t* E; float* ssq;
    __device__ __forceinline__ void operator()(const f32x4 (&acc)[2][2][4][2], const Unit& u, int wr, int wc, int fr, int fq) const {
        const int row0 = u.pm * BM + wr * 64 + fr, col0 = u.pn * BM + wc * 32 + 8 * fq;
#pragma unroll
        for (int ai = 0; ai < 2; ++ai)
#pragma unroll
            for (int m = 0; m < 4; ++m) { const int row = row0 + ai * HALF + m * 16; const size_t off = (size_t)row * 1024 + col0; float s = 0.f;
#pragma unroll
                for (int bj = 0; bj < 2; ++bj) { *(u32x4*)(E + off + bj * HALF) = pack8(acc[ai][bj][m][0], acc[ai][bj][m][1]); s += sq4(acc[ai][bj][m][0]) + sq4(acc[ai][bj][m][1]); }
                s += __shfl_xor(s, 16); s += __shfl_xor(s, 32);
                if (fq == 0) ssq[(size_t)row * 16 + u.pn * 4 + wc] = s; }
    }
};
struct EpiPle {
    static constexpr bool PERM = true, AFTER_DRAIN = false;
    float* out; const bf16_t* E; const float* ssq_h; const float* ssq_e; const float* gain;
    __device__ __forceinline__ void operator()(const f32x4 (&acc)[2][2][4][2], const Unit& u, int wr, int wc, int fr, int fq) const {
        const int row0 = u.pm * BM + wr * 64 + fr, col0 = u.pn * BM + wc * 32 + 8 * fq;
        f32x4 gv[2][2];
#pragma unroll
        for (int bj = 0; bj < 2; ++bj) { gv[bj][0] = *(const f32x4*)(gain + col0 + bj * HALF); gv[bj][1] = *(const f32x4*)(gain + col0 + bj * HALF + 4); }
#pragma unroll
        for (int ai = 0; ai < 2; ++ai)
#pragma unroll
            for (int m = 0; m < 4; ++m) { const int row = row0 + ai * HALF + m * 16; const size_t off = (size_t)row * 1024 + col0;
                const float rh = rstd_row(ssq_h, row, 1.0f / 1024.0f), re = rstd_row(ssq_e, row, 1.0f / 1024.0f);
#pragma unroll
                for (int bj = 0; bj < 2; ++bj) { const u32x4 ew = *(const u32x4*)(E + off + bj * HALF);
                    const f32x4 b0 = *(const f32x4*)(out + off + bj * HALF), b1 = *(const f32x4*)(out + off + bj * HALF + 4);
                    f32x4 e0, e1; e0[0] = __uint_as_float(ew.x << 16); e0[1] = __uint_as_float(ew.x & 0xffff0000u); e0[2] = __uint_as_float(ew.y << 16); e0[3] = __uint_as_float(ew.y & 0xffff0000u);
                    e1[0] = __uint_as_float(ew.z << 16); e1[1] = __uint_as_float(ew.z & 0xffff0000u); e1[2] = __uint_as_float(ew.w << 16); e1[3] = __uint_as_float(ew.w & 0xffff0000u);
                    f32x4 o0, o1;
#pragma unroll
                    for (int j = 0; j < 4; ++j) { o0[j] = b0[j] + sigmoid_f(acc[ai][bj][m][0][j] * rh) * (e0[j] * re * gv[bj][0][j]); o1[j] = b1[j] + sigmoid_f(acc[ai][bj][m][1][j] * rh) * (e1[j] * re * gv[bj][1][j]); }
                    *(f32x4*)(out + off + bj * HALF) = o0; *(f32x4*)(out + off + bj * HALF + 4) = o1; }
                if (m & 1) asm volatile("" ::: "memory"); }
    }
};
template <class Epi, class Sched, bool ALIGN_EPI = false, bool SP2 = false>
__device__ __forceinline__ void gemm_phase(PG8_LAS unsigned char* lds, const Gemm g, const Sched& S, const Epi& E) {
    const int tid = threadIdx.x, wid = __builtin_amdgcn_readfirstlane(tid >> 6), lane = tid & 63, wr = wid >> 2, wc = wid & 3, fr = lane & 15, fq = lane >> 4;
    const int K = g.K, nt = K / BK;
    unsigned voffA[2], voffB[2];
#pragma unroll
    for (int i = 0; i < 2; ++i) { int R, C; stage_rc(tid * 16 + i * 8192, R, C); const int Rb = Epi::PERM ? ((R & ~31) + perm32(R & 31)) : R;
        voffA[i] = (unsigned)(R * K + C) * 2u; voffB[i] = (unsigned)(Rb * K + C) * 2u; }
    const size_t kstep = (size_t)(BK * 2);
    const size_t hstep = (size_t)HALF * K * 2;
    const size_t tstep = 2 * hstep;
    const unsigned ldsw = (unsigned)wid * 1024u;
    const int aoff = lds_byte(wr * 64 + fr, fq * 8), boff = lds_byte(wc * 32 + fr, fq * 8);
#define PG8_SA(b, h) (((b) * 2 + (h)) * HTB)
#define PG8_SB(b, h) ((4 + (b) * 2 + (h)) * HTB)
#define PG8_STAGE(bufoff, gbase, voff) do { _Pragma("unroll") for (int _i = 0; _i < 2; ++_i) \
        __builtin_amdgcn_global_load_lds((const unsigned*)((const char*)(gbase) + (voff)[_i]), (PG8_LAS unsigned*)(lds + (bufoff) + ldsw + _i * 8192), 16, 0, 0); } while (0)
#define PG8_LDA(dst, b, h) do { _Pragma("unroll") for (int m = 0; m < 4; ++m) _Pragma("unroll") for (int k = 0; k < 2; ++k) dst[m][k] = *(const PG8_LAS bf16x8*)(lds + PG8_SA(b, h) + aoff + m * 2048 + k * 1024); } while (0)
#define PG8_LDB(dst, b, h) do { _Pragma("unroll") for (int n = 0; n < 2; ++n) _Pragma("unroll") for (int k = 0; k < 2; ++k) dst[n][k] = *(const PG8_LAS bf16x8*)(lds + PG8_SB(b, h) + boff + n * 2048 + k * 1024); } while (0)
#define PG8_MMA(ai, bj, At, Bt) do { __builtin_amdgcn_s_setprio(1); _Pragma("unroll") for (int m = 0; m < 4; ++m) _Pragma("unroll") for (int n = 0; n < 2; ++n) _Pragma("unroll") for (int k = 0; k < 2; ++k) \
        acc[ai][bj][m][n] = __builtin_amdgcn_mfma_f32_16x16x32_bf16(Bt[n][k], At[m][k], acc[ai][bj][m][n], 0, 0, 0); __builtin_amdgcn_s_setprio(0); } while (0)
#define PG8_WAIT_V(n) asm volatile("s_waitcnt vmcnt(" #n ")" ::: "memory")
#define PG8_WAIT_L(n) asm volatile("s_waitcnt lgkmcnt(" #n ")" ::: "memory")
#define PG8_BAR __builtin_amdgcn_s_barrier()
#define PG8_SCHED __builtin_amdgcn_sched_barrier(0)
    Unit cur, nxt; int ui = 0;
    if (!S.next(0, cur)) return;
    f32x4 acc[2][2][4][2];
#pragma unroll
    for (int a = 0; a < 2; ++a)
#pragma unroll
        for (int b = 0; b < 2; ++b)
#pragma unroll
            for (int m = 0; m < 4; ++m)
#pragma unroll
                for (int n = 0; n < 2; ++n) acc[a][b][m][n] = (f32x4){0.f, 0.f, 0.f, 0.f};
    bf16x8 At[4][2], B0[2][2], B1[2][2];
    const char* cA = (const char*)g.A + (size_t)cur.pm * tstep; const char* cB = (const char*)g.Bt + (size_t)cur.pn * tstep;
    S.a_ready(cur);
    if constexpr (SP2) {
        PG8_STAGE(PG8_SB(0, 0), cB, voffB); PG8_STAGE(PG8_SB(0, 1), cB + hstep, voffB); PG8_STAGE(PG8_SA(0, 0), cA, voffA); PG8_STAGE(PG8_SA(0, 1), cA + hstep, voffA);
        if (wr == 1) PG8_BAR;
        PG8_WAIT_V(2); PG8_BAR;
        PG8_STAGE(PG8_SB(1, 0), cB + kstep, voffB); PG8_STAGE(PG8_SA(1, 0), cA + kstep, voffA); PG8_STAGE(PG8_SB(1, 1), cB + hstep + kstep, voffB);
        PG8_WAIT_V(6); PG8_BAR;
    } else {
        PG8_STAGE(PG8_SB(0, 0), cB, voffB); PG8_STAGE(PG8_SA(0, 0), cA, voffA); PG8_STAGE(PG8_SB(0, 1), cB + hstep, voffB); PG8_STAGE(PG8_SA(0, 1), cA + hstep, voffA);
        if (wr == 1) PG8_BAR;
        PG8_WAIT_V(4); PG8_BAR;
        PG8_STAGE(PG8_SB(1, 0), cB + kstep, voffB); PG8_STAGE(PG8_SA(1, 0), cA + kstep, voffA); PG8_STAGE(PG8_SB(1, 1), cB + hstep + kstep, voffB);
        PG8_WAIT_V(6); PG8_BAR;
    }
    for (;;) {
        const bool has_next = S.next(ui + 1, nxt);
        const char* nA = has_next ? (const char*)g.A + (size_t)nxt.pm * tstep : cA; const char* nB = has_next ? (const char*)g.Bt + (size_t)nxt.pn * tstep : cB;
        for (int t = 0; t < nt; t += 2) {
            const bool last = (t == nt - 2);
            const char* a1 = cA + (size_t)(t + 1) * kstep;
            const char* a2 = last ? nA : cA + (size_t)(t + 2) * kstep; const char* b2 = last ? nB : cB + (size_t)(t + 2) * kstep;
            const char* a3 = a2 + kstep; const char* b3 = b2 + kstep;
            if (last && has_next) S.a_ready(nxt);
            if constexpr (SP2) {
            PG8_LDB(B0, 0, 0); PG8_LDB(B1, 0, 1); PG8_SCHED; PG8_LDA(At, 0, 0); PG8_STAGE(PG8_SA(1, 1), a1 + hstep, voffA);
            PG8_WAIT_V(8); PG8_WAIT_L(0); PG8_BAR; PG8_MMA(0, 0, At, B0); PG8_MMA(0, 1, At, B1); PG8_BAR; PG8_SCHED;
            PG8_LDA(At, 0, 1); PG8_STAGE(PG8_SB(0, 0), b2, voffB); PG8_STAGE(PG8_SB(0, 1), b2 + hstep, voffB); PG8_STAGE(PG8_SA(0, 0), a2, voffA);
            PG8_WAIT_V(8); PG8_WAIT_L(0); PG8_BAR; PG8_MMA(1, 0, At, B0); PG8_MMA(1, 1, At, B1); PG8_BAR; PG8_SCHED;
            PG8_LDB(B0, 1, 0); PG8_LDB(B1, 1, 1); PG8_SCHED; PG8_LDA(At, 1, 0); PG8_STAGE(PG8_SA(0, 1), a2 + hstep, voffA);
            PG8_WAIT_V(8); PG8_WAIT_L(0); PG8_BAR; PG8_MMA(0, 0, At, B0); PG8_MMA(0, 1, At, B1); PG8_BAR; PG8_SCHED;
            PG8_LDA(At, 1, 1); PG8_STAGE(PG8_SB(1, 0), b3, voffB); PG8_STAGE(PG8_SB(1, 1), b3 + hstep, voffB); PG8_STAGE(PG8_SA(1, 0), a3, voffA);
            PG8_WAIT_V(8); PG8_WAIT_L(0); PG8_BAR; PG8_MMA(1, 0, At, B0); PG8_MMA(1, 1, At, B1); PG8_BAR; PG8_SCHED;
            } else {
            PG8_LDB(B0, 0, 0); PG8_SCHED; PG8_LDA(At, 0, 0); PG8_STAGE(PG8_SA(1, 1), a1 + hstep, voffA);
            PG8_WAIT_L(8); PG8_BAR; PG8_WAIT_L(0); PG8_MMA(0, 0, At, B0); PG8_BAR; PG8_SCHED;
            PG8_LDB(B1, 0, 1); PG8_STAGE(PG8_SB(0, 0), b2, voffB);
            PG8_BAR; PG8_WAIT_L(0); PG8_MMA(0, 1, At, B1); PG8_BAR;
            PG8_LDA(At, 0, 1); PG8_STAGE(PG8_SA(0, 0), a2, voffA);
            PG8_BAR; PG8_WAIT_L(0); PG8_MMA(1, 0, At, B0); PG8_BAR; PG8_SCHED;
            PG8_STAGE(PG8_SB(0, 1), b2 + hstep, voffB);
            PG8_WAIT_V(6); PG8_BAR; PG8_MMA(1, 1, At, B1); PG8_BAR;
            PG8_LDB(B0, 1, 0); PG8_SCHED; PG8_LDA(At, 1, 0); PG8_STAGE(PG8_SA(0, 1), a2 + hstep, voffA);
            PG8_WAIT_L(8); PG8_BAR; PG8_WAIT_L(0); PG8_MMA(0, 0, At, B0); PG8_BAR; PG8_SCHED;
            PG8_LDB(B1, 1, 1); PG8_STAGE(PG8_SB(1, 0), b3, voffB);
            PG8_BAR; PG8_WAIT_L(0); PG8_MMA(0, 1, At, B1); PG8_BAR;
            PG8_LDA(At, 1, 1); PG8_STAGE(PG8_SA(1, 0), a3, voffA);
            PG8_BAR; PG8_WAIT_L(0); PG8_MMA(1, 0, At, B0); PG8_BAR; PG8_SCHED;
            PG8_STAGE(PG8_SB(1, 1), b3 + hstep, voffB);
            PG8_WAIT_V(6); PG8_BAR; PG8_MMA(1, 1, At, B1); PG8_BAR;
            }
        }
        if constexpr (ALIGN_EPI) { if (wr == 0) PG8_BAR; }
        if constexpr (!Epi::AFTER_DRAIN) { E(acc, cur, wr, wc, fr, fq); S.done(cur); }
        if (!has_next) break;
#pragma unroll
        for (int a = 0; a < 2; ++a)
#pragma unroll
            for (int b = 0; b < 2; ++b)
#pragma unroll
                for (int m = 0; m < 4; ++m)
#pragma unroll
                    for (int n = 0; n < 2; ++n) acc[a][b][m][n] = (f32x4){0.f, 0.f, 0.f, 0.f};
        cur = nxt; cA = nA; cB = nB; ++ui;
        if constexpr (ALIGN_EPI) { if (wr == 1) PG8_BAR; }
    }
    PG8_WAIT_V(0);
    if constexpr (!ALIGN_EPI) { if (wr == 0) PG8_BAR; }
    PG8_BAR;
    if constexpr (Epi::AFTER_DRAIN) { E.fused(acc, cur, wr, wc, fr, fq, lds, wid, lane); S.done(cur); }
#undef PG8_SA
#undef PG8_SB
#undef PG8_STAGE
#undef PG8_LDA
#undef PG8_LDB
#undef PG8_MMA
#undef PG8_WAIT_V
#undef PG8_WAIT_L
#undef PG8_BAR
#undef PG8_SCHED
}
}
#include <hip/hip_cooperative_groups.h>
namespace cg = cooperative_groups;
constexpr int NWAVES = 8;
constexpr int T_ROWS = 32768, SEQ = 4096, DM = 1024, FF = 2816, NGU = 2 * FF, NIN = 2560, PLE = 256, ZP = NIN;
constexpr int ZC_AQ = 0, ZC_AK = 512, ZC_AV = 640, ZC_GQ = 768, ZC_GK = 1024, ZC_GV = 1280, ZC_GOG = 1792, ZC_GLR = 2304;
constexpr size_t MiB = 1u << 20;
constexpr size_t WS_CTL = 0, CTL_ZERO_BYTES = 1 * MiB;
constexpr size_t WS_TAB = 1 * MiB;
constexpr size_t WS_SSQ = 2 * MiB, SSQ_BYTES = 2 * MiB;
constexpr size_t WS_DEC = 12 * MiB;
constexpr size_t WS_W = 14 * MiB;
constexpr size_t W_1GU = WS_W, W_1D = W_1GU + (size_t)NGU * DM * 2, W_IN = W_1D + (size_t)DM * FF * 2, W_OUT = W_IN + (size_t)NIN * DM * 2, W_2GU = W_OUT + (size_t)DM * DM * 2,
                 W_2D = W_2GU + (size_t)NGU * DM * 2, W_PG = W_2D + (size_t)DM * FF * 2, W_PP = W_PG + (size_t)DM * DM * 2, W_END = W_PP + (size_t)DM * PLE * 2;
constexpr size_t WS_PB = 58 * MiB, WS_XB = 74 * MiB, WS_ACT = 138 * MiB, WS_MIX = 314 * MiB, WS_EMB = 378 * MiB, WS_GS = 442 * MiB, WS_END = 506 * MiB;
static_assert(W_END <= WS_PB && WS_ACT + (size_t)T_ROWS * FF * 2 <= WS_MIX && WS_ACT + (size_t)T_ROWS * ZP * 2 <= WS_MIX, "ws map");
constexpr int RING_BYTES = 131072, LDSCTL_OFF = RING_BYTES, LDS_BYTES = 147456;

typedef unsigned short bf16;
typedef float f32x4 __attribute__((ext_vector_type(4)));
typedef unsigned u32x4v __attribute__((ext_vector_type(4)));
typedef unsigned u32x2v __attribute__((ext_vector_type(2)));
#define LAS __attribute__((address_space(3)))
__device__ __forceinline__ unsigned f2bf(float f) { unsigned u = __builtin_bit_cast(unsigned, f); return (u + 0x7fffu + ((u >> 16) & 1u)) >> 16; }
__device__ __forceinline__ unsigned pk2(float lo, float hi) { return f2bf(lo) | (f2bf(hi) << 16); }
__device__ __forceinline__ float bf2f(unsigned short b) { return __uint_as_float((unsigned)b << 16); }
__device__ __forceinline__ float wave_sum(float v) {
#pragma unroll
    for (int o = 1; o < 64; o <<= 1) v += __shfl_xor(v, o);
    return v;
}
#define LDS_WAIT() asm volatile("s_waitcnt lgkmcnt(0)" ::: "memory")

__device__ __forceinline__ void p0_item(int kind, const float* a, const float* b, int ldn, const float* gain, int K, bf16* WT, int nblk, int item, LAS float* scr, int lane) {
    const int kb = item / nblk, nb = item % nblk, k0 = 64 * kb, P = 32 * nb + (lane & 31);
    const float* base = a; int col = P;
    if (kind == 1) { const int pn = P >> 8, bj = (P >> 7) & 1, q = P & 127; base = bj ? b : a; col = 128 * pn + q; }
    else if (kind == 2) { const int pn = P >> 8, p = P & 255, bj = p >> 7, wc = (p >> 5) & 3, r = p & 31, l = 256 * pn + 64 * wc + 32 * bj + r;
        if (l < 1792) col = l; else if (l < 2304) col = 1808 + (l - 1792); else if (l < 2320) col = 1792 + (l - 2304); else base = nullptr; }
#pragma unroll 8
    for (int i = 0; i < 32; ++i) { const int kk = 2 * i + (lane >> 5); float v = base ? base[(size_t)(k0 + kk) * ldn + col] : 0.f; if (gain) v *= gain[k0 + kk]; scr[kk * 33 + (lane & 31)] = v; }
    LDS_WAIT(); asm volatile("" ::: "memory");
    const int c = lane & 7;
#pragma unroll
    for (int j = 0; j < 4; ++j) { const int n = (lane >> 3) + 8 * j; const LAS float* s = scr + (8 * c) * 33 + n;
        u32x4v o; o.x = pk2(s[0 * 33], s[1 * 33]); o.y = pk2(s[2 * 33], s[3 * 33]); o.z = pk2(s[4 * 33], s[5 * 33]); o.w = pk2(s[6 * 33], s[7 * 33]);
        *(u32x4v*)(WT + (size_t)(32 * nb + n) * K + k0 + 8 * c) = o; }
    LDS_WAIT(); asm volatile("" ::: "memory");
}
struct Args { const float* in[23]; float* out; unsigned char* ws; int ph_lo, ph_hi; };
static_assert(sizeof(Args) == 26 * 8, "Args has no padding");

__device__ __forceinline__ void phase_prologue(const Args& A, LAS unsigned char* lds, int wave, int lane) {
    unsigned char* ws = A.ws;
    LAS float* scr = (LAS float*)(lds + wave * 16384);
    const int gw = blockIdx.x * NWAVES + wave, NGW = gridDim.x * NWAVES;
    constexpr int I_GU = (DM / 64) * (NGU / 32), I_D = (FF / 64) * (DM / 32), I_IN = (DM / 64) * (NIN / 32), I_SQ = (DM / 64) * (DM / 32), I_PP = (PLE / 64) * (DM / 32);
    constexpr int NITEMS = 2 * I_GU + 2 * I_D + I_IN + 2 * I_SQ + I_PP;
    for (int it = gw; it < NITEMS; it += NGW) {
        int r = it;
        if (r < I_GU) { p0_item(1, A.in[3], A.in[4], FF, A.in[2], DM, (bf16*)(ws + W_1GU), NGU / 32, r, scr, lane); continue; } r -= I_GU;
        if (r < I_GU) { p0_item(1, A.in[16], A.in[17], FF, A.in[15], DM, (bf16*)(ws + W_2GU), NGU / 32, r, scr, lane); continue; } r -= I_GU;
        if (r < I_D) { p0_item(0, A.in[5], nullptr, DM, nullptr, FF, (bf16*)(ws + W_1D), DM / 32, r, scr, lane); continue; } r -= I_D;
        if (r < I_D) { p0_item(0, A.in[18], nullptr, DM, nullptr, FF, (bf16*)(ws + W_2D), DM / 32, r, scr, lane); continue; } r -= I_D;
        if (r < I_IN) { p0_item(2, A.in[7], nullptr, 2320, A.in[6], DM, (bf16*)(ws + W_IN), NIN / 32, r, scr, lane); continue; } r -= I_IN;
        if (r < I_SQ) { p0_item(0, A.in[14], nullptr, DM, nullptr, DM, (bf16*)(ws + W_OUT), DM / 32, r, scr, lane); continue; } r -= I_SQ;
        if (r < I_SQ) { p0_item(0, A.in[20], nullptr, DM, A.in[19], DM, (bf16*)(ws + W_PG), DM / 32, r, scr, lane); continue; } r -= I_SQ;
        p0_item(0, A.in[21], nullptr, DM, nullptr, PLE, (bf16*)(ws + W_PP), DM / 32, r, scr, lane);
    }
    const float* x = A.in[0]; bf16* XB = (bf16*)(ws + WS_XB); float* ssq0 = (float*)(ws + WS_SSQ);
    for (int m = gw; m < T_ROWS; m += NGW) {
        const f32x4* xr = (const f32x4*)(x + (size_t)m * DM) + lane; f32x4 v[4]; float s = 0.f;
#pragma unroll
        for (int j = 0; j < 4; ++j) { v[j] = xr[64 * j]; s += (v[j][0] * v[j][0] + v[j][1] * v[j][1]) + (v[j][2] * v[j][2] + v[j][3] * v[j][3]); }
        s = wave_sum(s);
        u32x2v* o8 = (u32x2v*)(XB + (size_t)m * DM) + lane;
#pragma unroll
        for (int j = 0; j < 4; ++j) { u32x2v w; w.x = pk2(v[j][0], v[j][1]); w.y = pk2(v[j][2], v[j][3]); o8[64 * j] = w; }
        if (lane < 16) ssq0[(size_t)m * 16 + lane] = (lane == 0) ? s : 0.f;
    }
    const float* p = A.in[1]; bf16* PB = (bf16*)(ws + WS_PB);
    for (int m = gw; m < T_ROWS; m += NGW) { const f32x4 v = *((const f32x4*)(p + (size_t)m * PLE) + lane); u32x2v w; w.x = pk2(v[0], v[1]); w.y = pk2(v[2], v[3]); *((u32x2v*)(PB + (size_t)m * PLE) + lane) = w; }
    float* cosT = (float*)(ws + WS_TAB); float* sinT = cosT + SEQ * 32;
    for (int e = (blockIdx.x * NWAVES + wave) * 64 + lane; e < SEQ * 32; e += gridDim.x * NWAVES * 64) { const int pos = e >> 5, i = e & 31;
        const float inv = exp2f(-(float)(2 * i) * (1.0f / 64.0f) * 13.287712379549449f);
        const float ang = (float)pos * inv; const double rev = (double)ang * 0.15915494309189535; const float fr = (float)(rev - __builtin_floor(rev));
        cosT[e] = __builtin_amdgcn_cosf(fr); sinT[e] = __builtin_amdgcn_sinf(fr); }
}

__device__ __forceinline__ void phase_attn_naive(const Args& A) {
    const bf16* Z = (const bf16*)(A.ws + WS_ACT); bf16* MIX = (bf16*)(A.ws + WS_MIX); const float* sinks = A.in[10];
    const int gsz = gridDim.x * blockDim.x;
    for (int idx = blockIdx.x * blockDim.x + threadIdx.x; idx < T_ROWS * 8; idx += gsz) {
        const int row = idx >> 3, h = idx & 7, kvh = h >> 2, t = row & (SEQ - 1), rb = row - t;
        float q[64], o[64];
        const bf16* qp = Z + (size_t)row * ZP + ZC_AQ + 64 * h;
#pragma unroll
        for (int d = 0; d < 64; ++d) { q[d] = bf2f(qp[d]); o[d] = 0.f; }
        float mx = sinks[h], l = 0.f;
        const int j0 = t - 127 < 0 ? 0 : t - 127;
        for (int j = j0; j <= t; ++j) {
            const bf16* kp = Z + (size_t)(rb + j) * ZP + ZC_AK + 64 * kvh; const bf16* vp = Z + (size_t)(rb + j) * ZP + ZC_AV + 64 * kvh;
            float s = 0.f;
#pragma unroll
            for (int d = 0; d < 64; ++d) s += q[d] * bf2f(kp[d]);
            const float mn = fmaxf(mx, s), f = __expf(mx - mn), pe = __expf(s - mn);
            l = l * f + pe; mx = mn;
#pragma unroll
            for (int d = 0; d < 64; ++d) o[d] = o[d] * f + pe * bf2f(vp[d]);
        }
        l += __expf(sinks[h] - mx);
        const float il = 1.0f / l;
        bf16* op = MIX + (size_t)row * DM + 64 * h;
#pragma unroll
        for (int d = 0; d < 64; d += 2) *(unsigned*)(op + d) = pk2(o[d] * il, o[d + 1] * il);
    }
}

constexpr int GL_GL = 0, GL_WU = 4096, GL_BIAS = 8192, GL_B = 9216, GL_K = 25600, GL_Q = 41984, GL_V = 58368, GL_A = 74752, GL_S = 91136;
__device__ __forceinline__ void gla_load_common(const Args& A, LAS unsigned char* lds, int bh, int c, bool with_q) {
    const bf16* Z = (const bf16*)(A.ws + WS_ACT); const int tid = threadIdx.x, hh = bh & 3, row0 = (bh >> 2) * SEQ + c * 64;
    LAS float* gl = (LAS float*)(lds + GL_GL); LAS float* wu = (LAS float*)(lds + GL_WU); LAS float* bias = (LAS float*)(lds + GL_BIAS); LAS float* bt = (LAS float*)(lds + GL_B);
    LAS float* kt = (LAS float*)(lds + GL_K); LAS float* qt = (LAS float*)(lds + GL_Q); LAS unsigned short* vt = (LAS unsigned short*)(lds + GL_V);
    for (int e = tid; e < 1024; e += 512) { const int tok = e >> 4, r = e & 15; gl[e] = bf2f(Z[(size_t)(row0 + tok) * ZP + ZC_GLR + r]); }
    for (int e = tid; e < 1024; e += 512) { const int r = e >> 6, dk = e & 63; wu[e] = A.in[11][r * 256 + 64 * hh + dk]; }
    if (tid < 64) bias[tid] = A.in[12][64 * hh + tid];
    for (int e = tid; e < 4096; e += 512) { const int tok = e >> 6, dk = e & 63; kt[e] = bf2f(Z[(size_t)(row0 + tok) * ZP + ZC_GK + 64 * hh + dk]); if (with_q) qt[e] = bf2f(Z[(size_t)(row0 + tok) * ZP + ZC_GQ + 64 * hh + dk]); }
    for (int e = tid; e < 8192; e += 512) { const int tok = e >> 7, dv = e & 127; vt[e] = Z[(size_t)(row0 + tok) * ZP + ZC_GV + 128 * hh + dv]; }
    __syncthreads();
    for (int e = tid; e < 4096; e += 512) { const int tok = e >> 6, dk = e & 63; float z = bias[dk];
#pragma unroll
        for (int r = 0; r < 16; ++r) z += gl[tok * 16 + r] * wu[r * 64 + dk];
        const float ls = fminf(z, 0.f) - log1pf(__expf(-fabsf(z)));
        bt[e] = ls * (1.0f / 16.0f); }
    __syncthreads();
    if (tid < 64) { float run = 0.f; for (int tok = 0; tok < 64; ++tok) { run += bt[tok * 64 + tid]; bt[tok * 64 + tid] = run; } }
    __syncthreads();
}
__device__ __forceinline__ void phase_gla1(const Args& A, LAS unsigned char* lds) {
    float* DEC = (float*)(A.ws + WS_DEC); float* GS = (float*)(A.ws + WS_GS); const int tid = threadIdx.x;
    LAS float* bt = (LAS float*)(lds + GL_B); LAS float* kt = (LAS float*)(lds + GL_K); LAS unsigned short* vt = (LAS unsigned short*)(lds + GL_V);
    for (int u = blockIdx.x; u < 2048; u += gridDim.x) { const int bh = u >> 6, c = u & 63;
        gla_load_common(A, lds, bh, c, false);
        if (tid < 64) DEC[(size_t)u * 64 + tid] = __expf(bt[63 * 64 + tid]);
        const int dk = tid >> 3, dv0 = (tid & 7) * 16; float acc[16];
#pragma unroll
        for (int e = 0; e < 16; ++e) acc[e] = 0.f;
        const float bl = bt[63 * 64 + dk];
        for (int j = 0; j < 64; ++j) { const float w = kt[j * 64 + dk] * __expf(bl - bt[j * 64 + dk]);
#pragma unroll
            for (int e = 0; e < 16; ++e) acc[e] += w * bf2f(vt[j * 128 + dv0 + e]); }
        float* gp = GS + ((size_t)u * 64 + dk) * 128 + dv0;
#pragma unroll
        for (int e = 0; e < 16; e += 4) *(f32x4*)(gp + e) = (f32x4){acc[e], acc[e + 1], acc[e + 2], acc[e + 3]};
        __syncthreads(); }
}
__device__ __forceinline__ void phase_gla2(const Args& A) {
    const float* DEC = (const float*)(A.ws + WS_DEC); float* GS = (float*)(A.ws + WS_GS);
    for (int e = blockIdx.x * blockDim.x + threadIdx.x; e < 32 * 8192; e += gridDim.x * blockDim.x) { const int bh = e >> 13, rem = e & 8191, dk = rem >> 7; float S = 0.f;
        for (int c = 0; c < 64; ++c) { const size_t idx = ((size_t)(bh * 64 + c)) * 8192 + rem; const float tmp = GS[idx]; GS[idx] = S; S = DEC[(size_t)(bh * 64 + c) * 64 + dk] * S + tmp; } }
}
__device__ __forceinline__ void phase_gla3(const Args& A, LAS unsigned char* lds) {
    const bf16* Z = (const bf16*)(A.ws + WS_ACT); bf16* MIX = (bf16*)(A.ws + WS_MIX); const float* GS = (const float*)(A.ws + WS_GS); const float* gon = A.in[13]; const int tid = threadIdx.x;
    LAS float* bt = (LAS float*)(lds + GL_B); LAS float* kt = (LAS float*)(lds + GL_K); LAS float* qt = (LAS float*)(lds + GL_Q); LAS unsigned short* vt = (LAS unsigned short*)(lds + GL_V);
    LAS float* At = (LAS float*)(lds + GL_A); LAS float* St = (LAS float*)(lds + GL_S);
    for (int u = blockIdx.x; u < 2048; u += gridDim.x) { const int bh = u >> 6, c = u & 63, hh = bh & 3, row0 = (bh >> 2) * SEQ + c * 64;
        gla_load_common(A, lds, bh, c, true);
        for (int e = tid; e < 8192; e += 512) St[e] = GS[(size_t)u * 8192 + e];
        for (int e = tid; e < 4096; e += 512) { const int i = e >> 6, j = e & 63; float a = 0.f;
            if (j <= i) { for (int dk = 0; dk < 64; ++dk) a += qt[i * 64 + dk] * kt[j * 64 + dk] * __expf(bt[i * 64 + dk] - bt[j * 64 + dk]); }
            At[e] = a; }
        __syncthreads();
        const int i = tid >> 3, dv0 = (tid & 7) * 16; float acc[16];
#pragma unroll
        for (int e = 0; e < 16; ++e) acc[e] = 0.f;
        for (int j = 0; j <= i; ++j) { const float a = At[i * 64 + j];
#pragma unroll
            for (int e = 0; e < 16; ++e) acc[e] += a * bf2f(vt[j * 128 + dv0 + e]); }
        for (int dk = 0; dk < 64; ++dk) { const float w = qt[i * 64 + dk] * __expf(bt[i * 64 + dk]);
#pragma unroll
            for (int e = 0; e < 16; ++e) acc[e] += w * St[dk * 128 + dv0 + e]; }
        float ss = 0.f;
#pragma unroll
        for (int e = 0; e < 16; ++e) ss += acc[e] * acc[e];
        ss += __shfl_xor(ss, 1); ss += __shfl_xor(ss, 2); ss += __shfl_xor(ss, 4);
        const float rn = __builtin_amdgcn_rsqf(ss * (1.0f / 128.0f) + 1e-6f);
        const bf16* gp = Z + (size_t)(row0 + i) * ZP + ZC_GOG + 128 * hh + dv0; bf16* op = MIX + (size_t)(row0 + i) * DM + 512 + 128 * hh + dv0;
#pragma unroll
        for (int e = 0; e < 16; e += 2) { const float g0 = bf2f(gp[e]), g1 = bf2f(gp[e + 1]);
            const float o0 = acc[e] * rn * gon[dv0 + e] * (g0 / (1.0f + __expf(-g0))), o1 = acc[e + 1] * rn * gon[dv0 + e + 1] * (g1 / (1.0f + __expf(-g1)));
            *(unsigned*)(op + e) = pk2(o0, o1); }
        __syncthreads(); }
}

constexpr int N_PHASES = 11;
__global__ void __launch_bounds__(NWAVES * 64, 2) hymba_fwd(Args args) {
    extern __shared__ __attribute__((aligned(16))) unsigned char lds_raw[];
    LAS unsigned char* lds = (LAS unsigned char*)lds_raw;
    cg::grid_group grid = cg::this_grid();
    const int tid = threadIdx.x, lane = tid & 63, wave = __builtin_amdgcn_readfirstlane(tid >> 6);
    const int G = gridDim.x, lo = args.ph_lo, hi = args.ph_hi;
    unsigned char* ws = args.ws;
    bf16* XB = (bf16*)(ws + WS_XB); bf16* ACT = (bf16*)(ws + WS_ACT); bf16* MIX = (bf16*)(ws + WS_MIX); bf16* EMB = (bf16*)(ws + WS_EMB); bf16* PB = (bf16*)(ws + WS_PB);
    float* SSQ0 = (float*)(ws + WS_SSQ); float* SSQ1 = SSQ0 + (size_t)T_ROWS * 16; float* SSQ2 = SSQ1 + (size_t)T_ROWS * 16; float* SSQ3 = SSQ2 + (size_t)T_ROWS * 16; float* SSQ4 = SSQ3 + (size_t)T_ROWS * 16;
    const float* cosT = (const float*)(ws + WS_TAB); const float* sinT = cosT + SEQ * 32;
#define IN(k) (lo <= (k) && (k) < hi)
#define SEAM(k) do { if (IN(k) && IN((k) + 1)) grid.sync(); } while (0)
    if (IN(0)) { phase_prologue(args, lds, wave, lane); __syncthreads(); } SEAM(0);
    if (IN(1)) {
        { pg8::Gemm g{XB, (const bf16*)(ws + W_1GU), T_ROWS, NGU, DM}; pg8::StaticOrder S; S.init(T_ROWS, NGU, G, (int)blockIdx.x);
          pg8::EpiSwiGLU E{ACT, FF, SSQ0}; pg8::gemm_phase<pg8::EpiSwiGLU, pg8::StaticOrder, true, true>(lds, g, S, E); }
        { pg8::Gemm g{PB, (const bf16*)(ws + W_PP), T_ROWS, DM, PLE}; pg8::StaticOrder S; S.init(T_ROWS, DM, G, (int)blockIdx.x);
          pg8::EpiEmb E{EMB, SSQ4}; pg8::gemm_phase<pg8::EpiEmb, pg8::StaticOrder, true, true>(lds, g, S, E); }
    } SEAM(1);
    if (IN(2)) { pg8::Gemm g{ACT, (const bf16*)(ws + W_1D), T_ROWS, DM, FF}; pg8::StaticOrder S; S.init(T_ROWS, DM, G, (int)blockIdx.x);
        pg8::EpiResid E{args.in[0], args.out, XB, SSQ1, 0.5f}; pg8::gemm_phase<pg8::EpiResid, pg8::StaticOrder, true, true>(lds, g, S, E); } SEAM(2);
    if (IN(3)) { pg8::Gemm g{XB, (const bf16*)(ws + W_IN), T_ROWS, NIN, DM}; pg8::StaticOrder S; S.init(T_ROWS, NIN, G, (int)blockIdx.x);
        pg8::EpiZ E{ACT, SSQ1, cosT, sinT, args.in[8], args.in[9]}; pg8::gemm_phase<pg8::EpiZ, pg8::StaticOrder, true, true>(lds, g, S, E); } SEAM(3);
    if (IN(4)) { phase_attn_naive(args); phase_gla1(args, lds); } SEAM(4);
    if (IN(5)) { phase_gla2(args); } SEAM(5);
    if (IN(6)) { phase_gla3(args, lds); } SEAM(6);
    if (IN(7)) { pg8::Gemm g{MIX, (const bf16*)(ws + W_OUT), T_ROWS, DM, DM}; pg8::StaticOrder S; S.init(T_ROWS, DM, G, (int)blockIdx.x);
        pg8::EpiResid E{args.out, args.out, XB, SSQ2, 1.0f}; pg8::gemm_phase<pg8::EpiResid, pg8::StaticOrder, true, true>(lds, g, S, E); } SEAM(7);
    if (IN(8)) { pg8::Gemm g{XB, (const bf16*)(ws + W_2GU), T_ROWS, NGU, DM}; pg8::StaticOrder S; S.init(T_ROWS, NGU, G, (int)blockIdx.x);
        pg8::EpiSwiGLU E{ACT, FF, SSQ2}; pg8::gemm_phase<pg8::EpiSwiGLU, pg8::StaticOrder, true, true>(lds, g, S, E); } SEAM(8);
    if (IN(9)) { pg8::Gemm g{ACT, (const bf16*)(ws + W_2D), T_ROWS, DM, FF}; pg8::StaticOrder S; S.init(T_ROWS, DM, G, (int)blockIdx.x);
        pg8::EpiResid E{args.out, args.out, XB, SSQ3, 0.5f}; pg8::gemm_phase<pg8::EpiResid, pg8::StaticOrder, true, true>(lds, g, S, E); } SEAM(9);
    if (IN(10)) { pg8::Gemm g{XB, (const bf16*)(ws + W_PG), T_ROWS, DM, DM}; pg8::StaticOrder S; S.init(T_ROWS, DM, G, (int)blockIdx.x);
        pg8::EpiPle E{args.out, EMB, SSQ3, SSQ4, args.in[22]}; pg8::gemm_phase<pg8::EpiPle, pg8::StaticOrder, true, true>(lds, g, S, E); }
#undef IN
#undef SEAM
}

#ifndef MK_N_LAUNCHES
#define MK_N_LAUNCHES 11
#endif
extern "C" void kernel_launch(void* const* d_in, const int* in_sizes, int n_in, void* d_out, int out_size, void* d_ws, size_t ws_size, hipStream_t stream) {
    static int grid = 0;
    if (grid == 0) {
        if (n_in != 23 || out_size != T_ROWS * DM || ws_size < WS_END) { fprintf(stderr, "kernel_launch: unexpected shapes: n_in %d out %d ws %zu (need %zu)\n", n_in, out_size, ws_size, (size_t)WS_END); grid = -1; return; }
        int dev = 0, cus = 0, per_cu = 0;
        if (hipGetDevice(&dev) != hipSuccess || hipDeviceGetAttribute(&cus, hipDeviceAttributeMultiprocessorCount, dev) != hipSuccess) { grid = -1; return; }
        if (hipFuncSetAttribute((const void*)hymba_fwd, hipFuncAttributeMaxDynamicSharedMemorySize, LDS_BYTES) != hipSuccess) { fprintf(stderr, "kernel_launch: hipFuncSetAttribute failed\n"); grid = -1; return; }
        if (hipOccupancyMaxActiveBlocksPerMultiprocessor(&per_cu, (const void*)hymba_fwd, NWAVES * 64, LDS_BYTES) != hipSuccess || per_cu < 1) { fprintf(stderr, "kernel_launch: occupancy query says %d\n", per_cu); per_cu = 1; }
        (void)hipGetLastError();
        grid = cus;
        fprintf(stderr, "kernel_launch: cus %d per_cu %d grid %d ws %zu\n", cus, per_cu, grid, ws_size);
    }
    if (grid < 0) return;
    Args a{};
    for (int i = 0; i < 23; ++i) a.in[i] = (const float*)d_in[i];
    a.out = (float*)d_out; a.ws = (unsigned char*)d_ws;
    for (int li = 0; li < MK_N_LAUNCHES; ++li) {
        a.ph_lo = (MK_N_LAUNCHES == 1) ? 0 : li; a.ph_hi = (MK_N_LAUNCHES == 1) ? N_PHASES : li + 1;
        void* kargs[] = {&a};
        hipError_t e = hipLaunchCooperativeKernel((void*)hymba_fwd, dim3(grid), dim3(NWAVES * 64), kargs, LDS_BYTES, stream);
        if (e != hipSuccess) { fprintf(stderr, "kernel_launch: launch %d failed: %s\n", li, hipGetErrorString(e)); break; }
    }
}
```

```cpp
#include <hip/hip_runtime.h>
#include <cstdio>
#include <cstdint>
namespace pg8 {
#define PG8_LAS __attribute__((address_space(3)))
typedef unsigned short bf16_t;
typedef short bf16x8 __attribute__((ext_vector_type(8)));
typedef float f32x4 __attribute__((ext_vector_type(4)));
typedef unsigned u32x4 __attribute__((ext_vector_type(4)));
constexpr int BM = 256, BK = 64, HALF = 128, HTB = HALF * BK * 2  , STAGE_BYTES = 8 * HTB, NXCD = 8, WGM = 8;

__host__ __device__ __forceinline__ int lds_byte(int r, int c) { const int st = (r >> 4) * 2 + (c >> 5), rr = r & 15, cc = c & 31, ob = rr * 64 + cc * 2; return st * 1024 + (ob ^ (((ob >> 9) & 1) << 5)); }
__host__ __device__ __forceinline__ void stage_rc(int b, int& R, int& C) { const int st = b / 1024, sb = b % 1024, swz = sb ^ (((sb >> 9) & 1) << 5); R = (st >> 1) * 16 + swz / 64; C = (st & 1) * 32 + (swz % 64) / 2; }
__host__ __device__ __forceinline__ int perm32(int rho) { const int n = rho >> 4, i = rho & 15; return 8 * (i >> 2) + 4 * n + (i & 3); }

struct Unit { int pm, pn, aux; };
struct Gemm { const bf16_t* A; const bf16_t* Bt; int M, N, K; };

struct StaticOrder {
    int nM, nN, nwg, G, c;
    __host__ __device__ __forceinline__ void init(int M, int N, int G_, int c_) { nM = M / BM; nN = N / BM; nwg = nM * nN; G = G_; c = c_; }
    __host__ __device__ __forceinline__ bool next(int i, Unit& u) const {
        const long L = (long)i * G + c; if (L >= nwg) return false;
        int wgid = (int)L; { const int q = nwg / NXCD, r = nwg % NXCD, xcd = wgid % NXCD, off = wgid / NXCD; wgid = (xcd < r ? xcd * (q + 1) : r * (q + 1) + (xcd - r) * q) + off; }
        const int nig = WGM * nN, gid = wgid / nig, fm = gid * WGM, gsz = (nM - fm) < WGM ? (nM - fm) : WGM;
        u.pm = fm + ((wgid % nig) % gsz); u.pn = (wgid % nig) / gsz; return true;
    }
    __device__ __forceinline__ void a_ready(const Unit&) const {}
    __device__ __forceinline__ void done(const Unit&) const {}
};
__device__ __forceinline__ unsigned cvt_pk_bf16(float lo, float hi) { unsigned r; asm volatile("v_cvt_pk_bf16_f32 %0, %1, %2" : "=v"(r) : "v"(lo), "v"(hi)); return r; }
typedef float f32x2 __attribute__((ext_vector_type(2)));
constexpr float RMS_EPS = 1e-6f;
__device__ __forceinline__ void st16_wt(void* p, const u32x4 v) { asm volatile("global_store_dwordx4 %0, %1, off sc1\n\ts_nop 1" :: "v"(p), "v"(v) : "memory"); }
constexpr int Z_PANEL = 256 * 2816, Z_PITCH = 2560;
__device__ __forceinline__ size_t zoff(int row) { return (size_t)(row >> 8) * Z_PANEL + (size_t)(row & 255) * Z_PITCH; }
constexpr int SSQ_LD = 32768;
__device__ __forceinline__ float rstd_row(const float* ssq, int row, int nslots, float inv_n) {
    float s;
    if (nslots == 1) s = ssq[row];
    else { float v[16];
#pragma unroll
        for (int k = 0; k < 16; ++k) v[k] = ssq[(size_t)k * SSQ_LD + row];
        s = (((v[0] + v[1]) + (v[2] + v[3])) + ((v[4] + v[5]) + (v[6] + v[7]))) + (((v[8] + v[9]) + (v[10] + v[11])) + ((v[12] + v[13]) + (v[14] + v[15]))); }
    return __builtin_amdgcn_rsqf(s * inv_n + RMS_EPS); }
__device__ __forceinline__ float silu_f(float x) { return x * __builtin_amdgcn_rcpf(1.0f + __builtin_amdgcn_exp2f(-1.4426950408889634f * x)); }
__device__ __forceinline__ float sigmoid_f(float x) { return __builtin_amdgcn_rcpf(1.0f + __builtin_amdgcn_exp2f(-1.4426950408889634f * x)); }
__device__ __forceinline__ u32x4 pack8(const f32x4 a, const f32x4 b) { u32x4 w; w.x = cvt_pk_bf16(a[0], a[1]); w.y = cvt_pk_bf16(a[2], a[3]); w.z = cvt_pk_bf16(b[0], b[1]); w.w = cvt_pk_bf16(b[2], b[3]); return w; }
__device__ __forceinline__ float sq4(const f32x4 a) { return (a[0] * a[0] + a[1] * a[1]) + (a[2] * a[2] + a[3] * a[3]); }

typedef float f32x2 __attribute__((ext_vector_type(2)));
__device__ __forceinline__ f32x4 exp2_4(const f32x4 t) { return (f32x4){__builtin_amdgcn_exp2f(t[0]), __builtin_amdgcn_exp2f(t[1]), __builtin_amdgcn_exp2f(t[2]), __builtin_amdgcn_exp2f(t[3])}; }
__device__ __forceinline__ f32x4 rcp_4(const f32x4 t) { return (f32x4){__builtin_amdgcn_rcpf(t[0]), __builtin_amdgcn_rcpf(t[1]), __builtin_amdgcn_rcpf(t[2]), __builtin_amdgcn_rcpf(t[3])}; }
struct EpiSwiGLU {
    static constexpr bool PERM = true, AFTER_DRAIN = false;
    bf16_t* O; int ldo; const PG8_LAS float* rt; int pm1, pm2, pm3;
    __device__ __forceinline__ void operator()(const f32x4 (&acc)[2][2][4][2], const Unit& u, int wr, int wc, int fr, int fq) const {
        const int row0 = u.pm * BM + wr * 64 + fr, col0 = u.pn * HALF + wc * 32 + 8 * fq; const PG8_LAS float* rp = rt + 256 * ((u.pm == pm1) + 2 * (u.pm == pm2) + 3 * (u.pm == pm3)) + wr * 64 + fr;
#pragma unroll
        for (int ai = 0; ai < 2; ++ai)
#pragma unroll
            for (int m = 0; m < 4; ++m) { const int row = row0 + ai * HALF + m * 16; const float r = rp[ai * HALF + m * 16], nr = r * -1.4426950408889634f, r2 = r * r;
                f32x4 o[2];
#pragma unroll
                for (int n = 0; n < 2; ++n) { const f32x4 g = acc[ai][0][m][n], up = acc[ai][1][m][n]; const f32x4 q = rcp_4(exp2_4(g * nr) + 1.0f); o[n] = ((g * up) * r2) * q; }
                st16_wt(O + (size_t)row * ldo + col0, pack8(o[0], o[1])); }
    }
};
__device__ __forceinline__ void unpack8(const u32x4 w, f32x4& a, f32x4& b) {
    a[0] = __uint_as_float(w.x << 16); a[1] = __uint_as_float(w.x & 0xffff0000u); a[2] = __uint_as_float(w.y << 16); a[3] = __uint_as_float(w.y & 0xffff0000u);
    b[0] = __uint_as_float(w.z << 16); b[1] = __uint_as_float(w.z & 0xffff0000u); b[2] = __uint_as_float(w.w << 16); b[3] = __uint_as_float(w.w & 0xffff0000u);
}
struct EpiResid {
    static constexpr bool PERM = true, AFTER_DRAIN = false;
    bf16_t* hb; float* ssq; float scale;
    __device__ __forceinline__ void operator()(const f32x4 (&acc)[2][2][4][2], const Unit& u, int wr, int wc, int fr, int fq) const {
        const int row0 = u.pm * BM + wr * 64 + fr, col0 = u.pn * BM + wc * 32 + 8 * fq;
        const float sc = u.aux ? 0.f : scale;
        u32x4 bw[2][4][2];
#pragma unroll
        for (int ai = 0; ai < 2; ++ai)
#pragma unroll
            for (int m = 0; m < 4; ++m)
#pragma unroll
                for (int bj = 0; bj < 2; ++bj) bw[ai][m][bj] = *(const u32x4*)(hb + (size_t)(row0 + ai * HALF + m * 16) * 1024 + col0 + bj * HALF);
#pragma unroll
        for (int ai = 0; ai < 2; ++ai)
#pragma unroll
            for (int m = 0; m < 4; ++m) { const int row = row0 + ai * HALF + m * 16; const size_t off = (size_t)row * 1024 + col0; float s = 0.f;
#pragma unroll
                for (int bj = 0; bj < 2; ++bj) { f32x4 b0, b1; unpack8(bw[ai][m][bj], b0, b1);
                    const f32x4 h0 = b0 + acc[ai][bj][m][0] * sc, h1 = b1 + acc[ai][bj][m][1] * sc;
                    *(u32x4*)(hb + off + bj * HALF) = pack8(h0, h1); s += sq4(h0) + sq4(h1); }
                s += __shfl_xor(s, 16); s += __shfl_xor(s, 32);
                if (fq == 0) ssq[(size_t)(u.pn * 4 + wc) * SSQ_LD + row] = s; }
    }
};
struct EpiZ {
    static constexpr bool PERM = true, AFTER_DRAIN = false;
    bf16_t* Z; const PG8_LAS float* rt; int pm1, pm2, pm3; const float* cosT; const float* sinT; const float* qn; const float* kn;
    __device__ __forceinline__ void operator()(const f32x4 (&acc)[2][2][4][2], const Unit& u, int wr, int wc, int fr, int fq) const {
        const int row0 = u.pm * BM + wr * 64 + fr, col0 = u.pn * BM + wc * 64 + 8 * fq; const PG8_LAS float* rp = rt + 256 * ((u.pm == pm1) + 2 * (u.pm == pm2) + 3 * (u.pm == pm3)) + wr * 64 + fr;
        const bool rope = (u.pn < 2) || (u.pn == 2 && wc < 2);
        const float osc = (u.pn < 2) ? 0.125f * 1.4426950408889634f : (u.pn == 3 ? 0.125f : 1.0f);
        if (rope) {
            const float* gn = (u.pn < 2) ? qn : kn;
            const f32x4 gl0 = *(const f32x4*)(gn + 8 * fq) * osc, gl1 = *(const f32x4*)(gn + 8 * fq + 4) * osc, gh0 = *(const f32x4*)(gn + 32 + 8 * fq) * osc, gh1 = *(const f32x4*)(gn + 32 + 8 * fq + 4) * osc;
#pragma unroll
            for (int aim = 0; aim < 4; ++aim) { const int ai = aim >> 1, mb = (aim & 1) * 2;
                f32x4 c0[4], c1[4], s0[4], s1[4];
#pragma unroll
                for (int m = mb; m < mb + 2; ++m) { const int pos = (row0 + ai * HALF + m * 16) & 4095;
                    c0[m] = *(const f32x4*)(cosT + pos * 32 + 8 * fq); c1[m] = *(const f32x4*)(cosT + pos * 32 + 8 * fq + 4); s0[m] = *(const f32x4*)(sinT + pos * 32 + 8 * fq); s1[m] = *(const f32x4*)(sinT + pos * 32 + 8 * fq + 4); }
#pragma unroll
                for (int m = mb; m < mb + 2; ++m) { const int row = row0 + ai * HALF + m * 16; const float r1 = rp[ai * HALF + m * 16];
                    f32x4 lo0 = acc[ai][0][m][0] * r1, lo1 = acc[ai][0][m][1] * r1, hi0 = acc[ai][1][m][0] * r1, hi1 = acc[ai][1][m][1] * r1;
                    float ss = (sq4(lo0) + sq4(lo1)) + (sq4(hi0) + sq4(hi1)); ss += __shfl_xor(ss, 16); ss += __shfl_xor(ss, 32);
                    const float rn = __builtin_amdgcn_rsqf(ss * (1.0f / 64.0f) + RMS_EPS);
                    lo0 = lo0 * rn * gl0; lo1 = lo1 * rn * gl1; hi0 = hi0 * rn * gh0; hi1 = hi1 * rn * gh1;
                    const f32x4 nl0 = lo0 * c0[m] - hi0 * s0[m], nl1 = lo1 * c1[m] - hi1 * s1[m], nh0 = hi0 * c0[m] + lo0 * s0[m], nh1 = hi1 * c1[m] + lo1 * s1[m];
                    bf16_t* zp = Z + zoff(row) + col0;
                    *(u32x4*)(zp) = pack8(nl0, nl1); *(u32x4*)(zp + 32) = pack8(nh0, nh1); }
                asm volatile("" ::: "memory"); }
        } else {
#pragma unroll
            for (int ai = 0; ai < 2; ++ai)
#pragma unroll
                for (int m = 0; m < 4; ++m) { const int row = row0 + ai * HALF + m * 16; const float r1 = rp[ai * HALF + m * 16] * osc;
                    bf16_t* zp = Z + zoff(row) + col0;
                    *(u32x4*)(zp) = pack8(acc[ai][0][m][0] * r1, acc[ai][0][m][1] * r1); *(u32x4*)(zp + 32) = pack8(acc[ai][1][m][0] * r1, acc[ai][1][m][1] * r1); }
        }
    }
};
struct EpiEmb {
    static constexpr bool PERM = true, AFTER_DRAIN = false;
    bf16_t* E; float* ssq;
    __device__ __forceinline__ void operator()(const f32x4 (&acc)[2][2][4][2], const Unit& u, int wr, int wc, int fr, int fq) const {
        const int row0 = u.pm * BM + wr * 64 + fr, col0 = u.pn * BM + wc * 32 + 8 * fq;
#pragma unroll
        for (int ai = 0; ai < 2; ++ai)
#pragma unroll
            for (int m = 0; m < 4; ++m) { const int row = row0 + ai * HALF + m * 16; const size_t off = (size_t)row * 1024 + col0; float s = 0.f;
#pragma unroll
                for (int bj = 0; bj < 2; ++bj) { *(u32x4*)(E + off + bj * HALF) = pack8(acc[ai][bj][m][0], acc[ai][bj][m][1]); s += sq4(acc[ai][bj][m][0]) + sq4(acc[ai][bj][m][1]); }
                s += __shfl_xor(s, 16); s += __shfl_xor(s, 32);
                if (fq == 0) ssq[(size_t)(u.pn * 4 + wc) * SSQ_LD + row] = s; }
    }
};
struct EpiPle {
    static constexpr bool PERM = true, AFTER_DRAIN = false;
    float* out; const bf16_t* hb; const bf16_t* E; const PG8_LAS float* rth; const PG8_LAS float* rte; int pm1, pm2, pm3; const float* gain;
    __device__ __forceinline__ void operator()(const f32x4 (&acc)[2][2][4][2], const Unit& u, int wr, int wc, int fr, int fq) const {
        const int row0 = u.pm * BM + wr * 64 + fr, col0 = u.pn * BM + wc * 32 + 8 * fq, ro = 256 * ((u.pm == pm1) + 2 * (u.pm == pm2) + 3 * (u.pm == pm3)) + wr * 64 + fr;
        f32x4 gv[2][2];
#pragma unroll
        for (int bj = 0; bj < 2; ++bj) { gv[bj][0] = *(const f32x4*)(gain + col0 + bj * HALF); gv[bj][1] = *(const f32x4*)(gain + col0 + bj * HALF + 4); }
#pragma unroll
        for (int aim = 0; aim < 4; ++aim) { const int ai = aim >> 1, mb = (aim & 1) * 2;
            u32x4 ew[4][2], hw[4][2];
#pragma unroll
            for (int m = mb; m < mb + 2; ++m)
#pragma unroll
                for (int bj = 0; bj < 2; ++bj) { const size_t off = (size_t)(row0 + ai * HALF + m * 16) * 1024 + col0 + bj * HALF; ew[m][bj] = *(const u32x4*)(E + off); hw[m][bj] = *(const u32x4*)(hb + off); }
#pragma unroll
            for (int m = mb; m < mb + 2; ++m) { const int row = row0 + ai * HALF + m * 16; const size_t off = (size_t)row * 1024 + col0;
                const float rh = rth[ro + ai * HALF + m * 16] * -1.4426950408889634f, re = rte[ro + ai * HALF + m * 16];
#pragma unroll
                for (int bj = 0; bj < 2; ++bj) { f32x4 e0, e1, b0, b1; unpack8(ew[m][bj], e0, e1); unpack8(hw[m][bj], b0, b1);
                    const f32x4 q0 = rcp_4(exp2_4(acc[ai][bj][m][0] * rh) + 1.0f), q1 = rcp_4(exp2_4(acc[ai][bj][m][1] * rh) + 1.0f);
                    const f32x4 o0 = b0 + q0 * ((e0 * re) * gv[bj][0]), o1 = b1 + q1 * ((e1 * re) * gv[bj][1]);
                    __builtin_nontemporal_store(o0, (f32x4*)(out + off + bj * HALF)); __builtin_nontemporal_store(o1, (f32x4*)(out + off + bj * HALF + 4)); } }
            asm volatile("" ::: "memory"); }
    }
};
struct EpiNone {
    static constexpr bool PERM = true, AFTER_DRAIN = false;
    __device__ __forceinline__ void operator()(const f32x4 (&acc)[2][2][4][2], const Unit& u, int wr, int wc, int fr, int fq) const {
#pragma unroll
        for (int ai = 0; ai < 2; ++ai)
#pragma unroll
            for (int bj = 0; bj < 2; ++bj)
#pragma unroll
                for (int m = 0; m < 4; ++m)
#pragma unroll
                    for (int n = 0; n < 2; ++n) asm volatile("" :: "v"(acc[ai][bj][m][n]));
    }
};
struct PreNone { __device__ __forceinline__ void operator()() const {} __device__ __forceinline__ void post() const {} };
template <class Epi, class Sched, bool ALIGN_EPI = false, bool SP2 = false, class Pre = PreNone>
__device__ __forceinline__ void gemm_phase(PG8_LAS unsigned char* lds, const Gemm g, const Sched& S, const Epi& E, const Pre& pre = Pre()) {
    const int tid = threadIdx.x, wid = __builtin_amdgcn_readfirstlane(tid >> 6), lane = tid & 63, wr = wid >> 2, wc = wid & 3, fr = lane & 15, fq = lane >> 4;
    const int K = g.K, nt = K / BK;
    unsigned voffA[2], voffB[2];
#pragma unroll
    for (int i = 0; i < 2; ++i) { int R, C; stage_rc(tid * 16 + i * 8192, R, C); const int Rb = Epi::PERM ? ((R & ~31) + perm32(R & 31)) : R;
        voffA[i] = (unsigned)(R * K + C) * 2u; voffB[i] = (unsigned)(Rb * K + C) * 2u; }
    const size_t kstep = (size_t)(BK * 2);
    const size_t hstep = (size_t)HALF * K * 2;
    const size_t tstep = 2 * hstep;
    const unsigned ldsw = (unsigned)wid * 1024u;
    const int aoff = lds_byte(wr * 64 + fr, fq * 8), boff = lds_byte(wc * 32 + fr, fq * 8);
#define PG8_SA(b, h) (((b) * 2 + (h)) * HTB)
#define PG8_SB(b, h) ((4 + (b) * 2 + (h)) * HTB)
#define PG8_STAGE(bufoff, gbase, voff) do { _Pragma("unroll") for (int _i = 0; _i < 2; ++_i) \
        __builtin_amdgcn_global_load_lds((const unsigned*)((const char*)(gbase) + (voff)[_i]), (PG8_LAS unsigned*)(lds + (bufoff) + ldsw + _i * 8192), 16, 0, 0); } while (0)
#define PG8_LDA(dst, b, h) do { _Pragma("unroll") for (int m = 0; m < 4; ++m) _Pragma("unroll") for (int k = 0; k < 2; ++k) dst[m][k] = *(const PG8_LAS bf16x8*)(lds + PG8_SA(b, h) + aoff + m * 2048 + k * 1024); } while (0)
#define PG8_LDB(dst, b, h) do { _Pragma("unroll") for (int n = 0; n < 2; ++n) _Pragma("unroll") for (int k = 0; k < 2; ++k) dst[n][k] = *(const PG8_LAS bf16x8*)(lds + PG8_SB(b, h) + boff + n * 2048 + k * 1024); } while (0)
#define PG8_MMA(ai, bj, At, Bt) do { __builtin_amdgcn_s_setprio(1); _Pragma("unroll") for (int m = 0; m < 4; ++m) _Pragma("unroll") for (int n = 0; n < 2; ++n) _Pragma("unroll") for (int k = 0; k < 2; ++k) \
        acc[ai][bj][m][n] = __builtin_amdgcn_mfma_f32_16x16x32_bf16(Bt[n][k], At[m][k], acc[ai][bj][m][n], 0, 0, 0); __builtin_amdgcn_s_setprio(0); } while (0)
#define PG8_WAIT_V(n) asm volatile("s_waitcnt vmcnt(" #n ")" ::: "memory")
#define PG8_WAIT_L(n) asm volatile("s_waitcnt lgkmcnt(" #n ")" ::: "memory")
#define PG8_BAR __builtin_amdgcn_s_barrier()
#define PG8_SCHED __builtin_amdgcn_sched_barrier(0)
    Unit cur, nxt; int ui = 0;
    if (!S.next(0, cur)) return;
    f32x4 acc[2][2][4][2];
#pragma unroll
    for (int a = 0; a < 2; ++a)
#pragma unroll
        for (int b = 0; b < 2; ++b)
#pragma unroll
            for (int m = 0; m < 4; ++m)
#pragma unroll
                for (int n = 0; n < 2; ++n) acc[a][b][m][n] = (f32x4){0.f, 0.f, 0.f, 0.f};
    bf16x8 At[4][2], B0[2][2], B1[2][2];
    const char* cA = (const char*)g.A + (size_t)cur.pm * tstep; const char* cB = (const char*)g.Bt + (size_t)cur.pn * tstep;
    S.a_ready(cur);
    if constexpr (SP2) {
        PG8_STAGE(PG8_SB(0, 0), cB, voffB); PG8_STAGE(PG8_SB(0, 1), cB + hstep, voffB); pre(); PG8_STAGE(PG8_SA(0, 0), cA, voffA); PG8_STAGE(PG8_SA(0, 1), cA + hstep, voffA); pre.post();
        if (wr == 1) PG8_BAR;
        PG8_WAIT_V(2); PG8_BAR;
        PG8_STAGE(PG8_SB(1, 0), cB + kstep, voffB); PG8_STAGE(PG8_SA(1, 0), cA + kstep, voffA); PG8_STAGE(PG8_SB(1, 1), cB + hstep + kstep, voffB);
        PG8_WAIT_V(6); PG8_BAR;
    } else {
        pre(); PG8_STAGE(PG8_SB(0, 0), cB, voffB); PG8_STAGE(PG8_SA(0, 0), cA, voffA); PG8_STAGE(PG8_SB(0, 1), cB + hstep, voffB); PG8_STAGE(PG8_SA(0, 1), cA + hstep, voffA);
        if (wr == 1) PG8_BAR;
        PG8_WAIT_V(4); PG8_BAR;
        PG8_STAGE(PG8_SB(1, 0), cB + kstep, voffB); PG8_STAGE(PG8_SA(1, 0), cA + kstep, voffA); PG8_STAGE(PG8_SB(1, 1), cB + hstep + kstep, voffB);
        PG8_WAIT_V(6); PG8_BAR;
    }
    for (;;) {
        const bool has_next = S.next(ui + 1, nxt);
        const char* nA = has_next ? (const char*)g.A + (size_t)nxt.pm * tstep : cA; const char* nB = has_next ? (const char*)g.Bt + (size_t)nxt.pn * tstep : cB;
        for (int t = 0; t < nt; t += 2) {
            const bool last = (t == nt - 2);
            const char* a1 = cA + (size_t)(t + 1) * kstep;
            const char* a2 = last ? nA : cA + (size_t)(t + 2) * kstep; const char* b2 = last ? nB : cB + (size_t)(t + 2) * kstep;
            const char* a3 = a2 + kstep; const char* b3 = b2 + kstep;
            if (last && has_next) S.a_ready(nxt);
            if constexpr (SP2) {
            PG8_LDB(B0, 0, 0); PG8_LDB(B1, 0, 1); PG8_SCHED; PG8_LDA(At, 0, 0); PG8_STAGE(PG8_SA(1, 1), a1 + hstep, voffA);
            PG8_WAIT_V(8); PG8_WAIT_L(0); PG8_BAR; PG8_MMA(0, 0, At, B0); PG8_MMA(0, 1, At, B1); PG8_BAR; PG8_SCHED;
            PG8_LDA(At, 0, 1); PG8_STAGE(PG8_SB(0, 0), b2, voffB); PG8_STAGE(PG8_SB(0, 1), b2 + hstep, voffB); PG8_STAGE(PG8_SA(0, 0), a2, voffA);
            PG8_WAIT_V(8); PG8_WAIT_L(0); PG8_BAR; PG8_MMA(1, 0, At, B0); PG8_MMA(1, 1, At, B1); PG8_BAR; PG8_SCHED;
            PG8_LDB(B0, 1, 0); PG8_LDB(B1, 1, 1); PG8_SCHED; PG8_LDA(At, 1, 0); PG8_STAGE(PG8_SA(0, 1), a2 + hstep, voffA);
            PG8_WAIT_V(8); PG8_WAIT_L(0); PG8_BAR; PG8_MMA(0, 0, At, B0); PG8_MMA(0, 1, At, B1); PG8_BAR; PG8_SCHED;
            PG8_LDA(At, 1, 1); PG8_STAGE(PG8_SB(1, 0), b3, voffB); PG8_STAGE(PG8_SB(1, 1), b3 + hstep, voffB); PG8_STAGE(PG8_SA(1, 0), a3, voffA);
            PG8_WAIT_V(8); PG8_WAIT_L(0); PG8_BAR; PG8_MMA(1, 0, At, B0); PG8_MMA(1, 1, At, B1); PG8_BAR; PG8_SCHED;
            } else {
            PG8_LDB(B0, 0, 0); PG8_SCHED; PG8_LDA(At, 0, 0); PG8_STAGE(PG8_SA(1, 1), a1 + hstep, voffA);
            PG8_WAIT_L(8); PG8_BAR; PG8_WAIT_L(0); PG8_MMA(0, 0, At, B0); PG8_BAR; PG8_SCHED;
            PG8_LDB(B1, 0, 1); PG8_STAGE(PG8_SB(0, 0), b2, voffB);
            PG8_BAR; PG8_WAIT_L(0); PG8_MMA(0, 1, At, B1); PG8_BAR;
            PG8_LDA(At, 0, 1); PG8_STAGE(PG8_SA(0, 0), a2, voffA);
            PG8_BAR; PG8_WAIT_L(0); PG8_MMA(1, 0, At, B0); PG8_BAR; PG8_SCHED;
            PG8_STAGE(PG8_SB(0, 1), b2 + hstep, voffB);
            PG8_WAIT_V(6); PG8_BAR; PG8_MMA(1, 1, At, B1); PG8_BAR;
            PG8_LDB(B0, 1, 0); PG8_SCHED; PG8_LDA(At, 1, 0); PG8_STAGE(PG8_SA(0, 1), a2 + hstep, voffA);
            PG8_WAIT_L(8); PG8_BAR; PG8_WAIT_L(0); PG8_MMA(0, 0, At, B0); PG8_BAR; PG8_SCHED;
            PG8_LDB(B1, 1, 1); PG8_STAGE(PG8_SB(1, 0), b3, voffB);
            PG8_BAR; PG8_WAIT_L(0); PG8_MMA(0, 1, At, B1); PG8_BAR;
            PG8_LDA(At, 1, 1); PG8_STAGE(PG8_SA(1, 0), a3, voffA);
            PG8_BAR; PG8_WAIT_L(0); PG8_MMA(1, 0, At, B0); PG8_BAR; PG8_SCHED;
            PG8_STAGE(PG8_SB(1, 1), b3 + hstep, voffB);
            PG8_WAIT_V(6); PG8_BAR; PG8_MMA(1, 1, At, B1); PG8_BAR;
            }
        }
        if constexpr (ALIGN_EPI) { if (wr == 0) PG8_BAR; }
        if constexpr (!Epi::AFTER_DRAIN) { E(acc, cur, wr, wc, fr, fq); S.done(cur); }
        if (!has_next) break;
#pragma unroll
        for (int a = 0; a < 2; ++a)
#pragma unroll
            for (int b = 0; b < 2; ++b)
#pragma unroll
                for (int m = 0; m < 4; ++m)
#pragma unroll
                    for (int n = 0; n < 2; ++n) acc[a][b][m][n] = (f32x4){0.f, 0.f, 0.f, 0.f};
        cur = nxt; cA = nA; cB = nB; ++ui;
        if constexpr (ALIGN_EPI) { if (wr == 1) PG8_BAR; }
    }
    PG8_WAIT_V(0);
    if constexpr (!ALIGN_EPI) { if (wr == 0) PG8_BAR; }
    PG8_BAR;
    if constexpr (Epi::AFTER_DRAIN) { E.fused(acc, cur, wr, wc, fr, fq, lds, wid, lane); S.done(cur); }
#undef PG8_SA
#undef PG8_SB
#undef PG8_STAGE
#undef PG8_LDA
#undef PG8_LDB
#undef PG8_MMA
#undef PG8_WAIT_V
#undef PG8_WAIT_L
#undef PG8_BAR
#undef PG8_SCHED
}
}
#ifndef PROBE_MASK
#define PROBE_MASK 0
#endif
#ifndef NTA
#define NTA 0
#endif
#include <hip/hip_cooperative_groups.h>
namespace cg = cooperative_groups;
constexpr int NWAVES = 8;
constexpr int T_ROWS = 32768, SEQ = 4096, DM = 1024, FF = 2816, NGU = 2 * FF, NIN = 2560, PLE = 256, ZP = NIN;
constexpr int ZC_AQ = 0, ZC_AK = 512, ZC_AV = 640, ZC_GQ = 768, ZC_GK = 1024, ZC_GV = 1280, ZC_GOG = 1792, ZC_GLR = 2304;
constexpr size_t MiB = 1u << 20;
constexpr size_t WS_CTL = 0, CTL_ZERO_BYTES = 1 * MiB;
constexpr size_t WS_TAB = 1 * MiB;
constexpr size_t WS_SSQ = 2 * MiB, SSQ_BYTES = 2 * MiB;
constexpr size_t WS_DEC = 12 * MiB;
constexpr size_t WS_AG = 12 * MiB + 768 * 1024;
constexpr size_t WS_W = 14 * MiB;
constexpr size_t W_1GU = WS_W, W_1D = W_1GU + (size_t)NGU * DM * 2, W_IN = W_1D + (size_t)DM * FF * 2, W_OUT = W_IN + (size_t)NIN * DM * 2, W_2GU = W_OUT + (size_t)DM * DM * 2,
                 W_2D = W_2GU + (size_t)NGU * DM * 2, W_PG = W_2D + (size_t)DM * FF * 2, W_PP = W_PG + (size_t)DM * DM * 2, W_END = W_PP + (size_t)DM * PLE * 2;
constexpr size_t WS_PB = 58 * MiB, WS_XB = 74 * MiB, WS_ACT = 138 * MiB, WS_MIX = 314 * MiB, WS_EMB = 378 * MiB, WS_GS = 442 * MiB, WS_END = 506 * MiB;
static_assert(W_END <= WS_PB && WS_ACT + (size_t)T_ROWS * FF * 2 <= WS_MIX, "ws map");
constexpr int RING_BYTES = 131072, LDSCTL_OFF = RING_BYTES, LDS_BYTES = 147456;

typedef unsigned short bf16;
typedef float f32x4 __attribute__((ext_vector_type(4)));
typedef unsigned u32x4v __attribute__((ext_vector_type(4)));
typedef unsigned u32x2v __attribute__((ext_vector_type(2)));
#define LAS __attribute__((address_space(3)))
__device__ __forceinline__ unsigned f2bf(float f) { unsigned u = __builtin_bit_cast(unsigned, f); return (u + 0x7fffu + ((u >> 16) & 1u)) >> 16; }
__device__ __forceinline__ unsigned pk2(float lo, float hi) { return f2bf(lo) | (f2bf(hi) << 16); }
__device__ __forceinline__ float bf2f(unsigned short b) { return __uint_as_float((unsigned)b << 16); }
__device__ __forceinline__ float wave_sum(float v) {
#pragma unroll
    for (int o = 1; o < 64; o <<= 1) v += __shfl_xor(v, o);
    return v;
}
#define LDS_WAIT() asm volatile("s_waitcnt lgkmcnt(0)" ::: "memory")
#define XB_TMO      128
#define XB_XCNT(j)  (256  + 64 * (j))
#define XB_XSUB(j)  (1280 + 64 * (j))
#define XB_XGEN(j)  (2304 + 64 * (j))
#define XB_TOP      3328
#define XB_TOPGEN   3392
#define XCD_BAR_WORDS 3456
#define XB_SPIN_CAP (1u << 18)

__device__ __forceinline__ unsigned xb_ld(unsigned* p)              { return __hip_atomic_load(p, __ATOMIC_RELAXED, __HIP_MEMORY_SCOPE_AGENT); }
__device__ __forceinline__ unsigned xb_add(unsigned* p, unsigned v) { return __hip_atomic_fetch_add(p, v, __ATOMIC_RELAXED, __HIP_MEMORY_SCOPE_AGENT); }
__device__ __forceinline__ unsigned xb_xcc_id() { return (unsigned)__builtin_amdgcn_s_getreg((3 << 11) | 20) & 0xFu; }
#define XB_SPIN(cond, bar) do { unsigned _sp = 0; while (cond) { __builtin_amdgcn_s_sleep(1); \
    if ((++_sp & 255u) == 0u) { if (xb_ld(&(bar)[XB_TMO])) break; if (_sp > XB_SPIN_CAP) { atomicAdd(&(bar)[XB_TMO], 1u); break; } } } } while (0)

struct XcdBarrier {
    unsigned* bar; unsigned x;
    volatile LAS unsigned* st;
};

__device__ __forceinline__ XcdBarrier xcd_barrier_post(unsigned* bar, volatile LAS unsigned* st) {
    XcdBarrier b; b.bar = bar; b.x = xb_xcc_id(); b.st = st;
    if (threadIdx.x == 0) (void)xb_add(&bar[XB_XCNT(b.x)], 1u);
    return b;
}
__device__ __forceinline__ void xcd_barrier_complete(unsigned* bar, unsigned x, unsigned& nloc, unsigned& nx) {
    const unsigned G = gridDim.x * gridDim.y * gridDim.z;
    unsigned sum, cnt, mine, sp = 0u;
    for (;;) {
        sum = 0u; cnt = 0u; mine = 0u;
#pragma unroll
        for (unsigned j = 0; j < 16; ++j) { const unsigned c = xb_ld(&bar[XB_XCNT(j)]); sum += c; cnt += (c > 0u) ? 1u : 0u; mine = (j == x) ? c : mine; }
        if (sum == G) break;
        __builtin_amdgcn_s_sleep(1);
        if ((++sp & 255u) == 0u) { if (xb_ld(&bar[XB_TMO])) break; if (sp > XB_SPIN_CAP) { atomicAdd(&bar[XB_TMO], 1u); break; } }
    }
    nloc = mine > 0u ? mine : 1u; nx = cnt > 0u ? cnt : 1u;
}

__device__ __forceinline__ void xcd_barrier(const XcdBarrier& b) {
    asm volatile("s_waitcnt vmcnt(0)" ::: "memory");
    __syncthreads();
    if (threadIdx.x == 0) {
        unsigned* bar = b.bar;
        __builtin_amdgcn_s_waitcnt(0);
        unsigned nloc = b.st[0], nx = b.st[1];
        if (nloc == 0u) { xcd_barrier_complete(bar, b.x, nloc, nx); b.st[0] = nloc; b.st[1] = nx; }
        const unsigned old = xb_add(&bar[XB_XSUB(b.x)], 1u);
        const unsigned gen = old / nloc;
        if (old + 1u == (gen + 1u) * nloc) {
            __builtin_amdgcn_fence(__ATOMIC_RELEASE, "agent");
            asm volatile("s_waitcnt vmcnt(0)" ::: "memory");
            const unsigned og = xb_add(&bar[XB_TOP], 1u);
            const unsigned tg = og / nx;
            if (og + 1u == (tg + 1u) * nx) xb_add(&bar[XB_TOPGEN], 1u);
            else XB_SPIN(xb_ld(&bar[XB_TOPGEN]) == tg, bar);
            __builtin_amdgcn_fence(__ATOMIC_ACQUIRE, "agent");
            xb_add(&bar[XB_XGEN(b.x)], 1u);
            asm volatile("s_waitcnt vmcnt(0)" ::: "memory");
        } else {
            XB_SPIN(xb_ld(&bar[XB_XGEN(b.x)]) == gen, bar);
            __builtin_amdgcn_fence(__ATOMIC_ACQUIRE, "agent");
            asm volatile("s_waitcnt vmcnt(0)" ::: "memory");
        }
    }
    __syncthreads();
}

constexpr int CW_TEAM = 4096, CW_TMASK = CW_TEAM + 128 * 64;
constexpr int CW_XG = CW_TMASK + 128 * 64, CW_XGMASK = CW_XG + 8 * 64;
constexpr size_t CTL_MEMSET_BYTES = (size_t)(CW_XGMASK + 8 * 64) * 4;
__device__ __forceinline__ void team_barrier(unsigned* ctl, int key, unsigned target, bool need_release, int cw_base = CW_TEAM) {
    asm volatile("s_waitcnt vmcnt(0)" ::: "memory");
    __syncthreads();
    if (threadIdx.x == 0) {
        if (need_release) { __builtin_amdgcn_fence(__ATOMIC_RELEASE, "agent"); asm volatile("s_waitcnt vmcnt(0)" ::: "memory"); }
        unsigned* cnt = ctl + cw_base + 64 * key;
        (void)__hip_atomic_fetch_add(cnt, 1u, __ATOMIC_RELAXED, __HIP_MEMORY_SCOPE_AGENT);
        unsigned sp = 0;
        while (__hip_atomic_load(cnt, __ATOMIC_RELAXED, __HIP_MEMORY_SCOPE_AGENT) < target) { __builtin_amdgcn_s_sleep(1); if (++sp > (1u << 22)) break; }
        __builtin_amdgcn_fence(__ATOMIC_ACQUIRE, "agent");
        asm volatile("s_waitcnt vmcnt(0)" ::: "memory");
    }
    __syncthreads();
}
__device__ __forceinline__ void hook_wait(unsigned* ctl, int key, unsigned target, int cw_base) {
    if (threadIdx.x == 0) { unsigned* cnt = ctl + cw_base + 64 * key; unsigned sp = 0;
        while (__hip_atomic_load(cnt, __ATOMIC_RELAXED, __HIP_MEMORY_SCOPE_AGENT) < target) { __builtin_amdgcn_s_sleep(1); if (++sp > (1u << 22)) break; }
        __builtin_amdgcn_fence(__ATOMIC_ACQUIRE, "agent");
        asm volatile("s_waitcnt vmcnt(0)" ::: "memory"); }
    asm volatile("" ::: "memory"); __builtin_amdgcn_s_barrier(); asm volatile("" ::: "memory");
}
__device__ __forceinline__ void group_arrive(unsigned* ctl, int key, bool need_release, int cw_base) {
    asm volatile("s_waitcnt vmcnt(0)" ::: "memory");
    __syncthreads();
    if (threadIdx.x == 0) {
        if (need_release) { __builtin_amdgcn_fence(__ATOMIC_RELEASE, "agent"); asm volatile("s_waitcnt vmcnt(0)" ::: "memory"); }
        (void)__hip_atomic_fetch_add(ctl + cw_base + 64 * key, 1u, __ATOMIC_RELAXED, __HIP_MEMORY_SCOPE_AGENT); }
}
__device__ __forceinline__ void group_wait(unsigned* ctl, int key, unsigned target, int cw_base) {
    if (threadIdx.x == 0) { unsigned* cnt = ctl + cw_base + 64 * key; unsigned sp = 0;
        while (__hip_atomic_load(cnt, __ATOMIC_RELAXED, __HIP_MEMORY_SCOPE_AGENT) < target) { __builtin_amdgcn_s_sleep(1); if (++sp > (1u << 22)) break; }
        __builtin_amdgcn_fence(__ATOMIC_ACQUIRE, "agent");
        asm volatile("s_waitcnt vmcnt(0)" ::: "memory"); }
    __syncthreads();
}
__device__ __forceinline__ void p0_item(int kind, const float* a, const float* b, int ldn, const float* gain, int K, bf16* WT, int nblk, int item, int lane) {
    const int kb = item / nblk, nb = item % nblk, k0 = 64 * kb + 8 * (lane >> 3), P = 32 * nb + 4 * (lane & 7);
    const float* base = a; int col = P;
    if (kind == 1) { const int pn = P >> 8, bj = (P >> 7) & 1, q = P & 127; base = bj ? b : a; col = 128 * pn + q; }
    else if (kind == 2) { const int pn = P >> 8, p = P & 255, bj = p >> 7, wc = (p >> 5) & 3, r = p & 31, l = 256 * pn + 64 * wc + 32 * bj + r;
        if (l < 1792) col = l; else if (l < 2304) col = 1808 + (l - 1792); else if (l < 2320) col = 1792 + (l - 2304); else base = nullptr; }
    f32x4 v[8];
#pragma unroll
    for (int j = 0; j < 8; ++j) v[j] = base ? *(const f32x4*)(base + (size_t)(k0 + j) * ldn + col) : (f32x4){0.f, 0.f, 0.f, 0.f};
    if (gain) { const f32x4 g0 = *(const f32x4*)(gain + k0), g1 = *(const f32x4*)(gain + k0 + 4);
#pragma unroll
        for (int j = 0; j < 4; ++j) { v[j] = v[j] * g0[j]; v[4 + j] = v[4 + j] * g1[j]; } }
#pragma unroll
    for (int i = 0; i < 4; ++i) { u32x4v o; o.x = pk2(v[0][i], v[1][i]); o.y = pk2(v[2][i], v[3][i]); o.z = pk2(v[4][i], v[5][i]); o.w = pk2(v[6][i], v[7][i]);
        *(u32x4v*)(WT + (size_t)(P + i) * K + k0) = o; }
}
struct Args { const float* in[23]; float* out; unsigned char* ws; int ph_lo, ph_hi; };
static_assert(sizeof(Args) == 26 * 8, "Args has no padding");

__device__ __forceinline__ void phase_prologue(const Args& A, LAS unsigned char* lds, int wave, int lane) {
    unsigned char* ws = A.ws;
    const int gw = blockIdx.x * NWAVES + wave, NGW = gridDim.x * NWAVES;
    constexpr int I_GU = (DM / 64) * (NGU / 32), I_D = (FF / 64) * (DM / 32), I_IN = (DM / 64) * (NIN / 32), I_SQ = (DM / 64) * (DM / 32), I_PP = (PLE / 64) * (DM / 32);
    constexpr int NITEMS = 2 * I_GU + 2 * I_D + I_IN + 2 * I_SQ + I_PP;
    for (int rp_ = 0; rp_ < (((PROBE_MASK) >> 23) & 1 ? 2 : 1); ++rp_)
    for (int it = gw; it < NITEMS; it += NGW) {
        int r = it;
        if (r < I_GU) { p0_item(1, A.in[3], A.in[4], FF, A.in[2], DM, (bf16*)(ws + W_1GU), NGU / 32, r, lane); continue; } r -= I_GU;
        if (r < I_GU) { p0_item(1, A.in[16], A.in[17], FF, A.in[15], DM, (bf16*)(ws + W_2GU), NGU / 32, r, lane); continue; } r -= I_GU;
        if (r < I_D) { p0_item(0, A.in[5], nullptr, DM, nullptr, FF, (bf16*)(ws + W_1D), DM / 32, r, lane); continue; } r -= I_D;
        if (r < I_D) { p0_item(0, A.in[18], nullptr, DM, nullptr, FF, (bf16*)(ws + W_2D), DM / 32, r, lane); continue; } r -= I_D;
        if (r < I_IN) { p0_item(2, A.in[7], nullptr, 2320, A.in[6], DM, (bf16*)(ws + W_IN), NIN / 32, r, lane); continue; } r -= I_IN;
        if (r < I_SQ) { p0_item(0, A.in[14], nullptr, DM, nullptr, DM, (bf16*)(ws + W_OUT), DM / 32, r, lane); continue; } r -= I_SQ;
        if (r < I_SQ) { p0_item(0, A.in[20], nullptr, DM, A.in[19], DM, (bf16*)(ws + W_PG), DM / 32, r, lane); continue; } r -= I_SQ;
        p0_item(0, A.in[21], nullptr, DM, nullptr, PLE, (bf16*)(ws + W_PP), DM / 32, r, lane);
    }
    const float* x = A.in[0]; bf16* XB = (bf16*)(ws + WS_XB); float* ssq0 = (float*)(ws + WS_SSQ);
    for (int rp_ = 0; rp_ < (((PROBE_MASK) >> 24) & 1 ? 2 : 1); ++rp_)
    for (int m = gw; m < T_ROWS; m += 2 * NGW) {
        f32x4 v[2][2][2]; float sq[2];
#pragma unroll
        for (int r = 0; r < 2; ++r) { const f32x4* xr = (const f32x4*)(x + (size_t)(m + r * NGW) * DM) + 2 * lane;
#pragma unroll
            for (int j = 0; j < 2; ++j) { v[r][j][0] = xr[128 * j]; v[r][j][1] = xr[128 * j + 1]; } }
#pragma unroll
        for (int r = 0; r < 2; ++r) { float s = 0.f;
#pragma unroll
            for (int j = 0; j < 2; ++j)
#pragma unroll
                for (int h = 0; h < 2; ++h) { const f32x4 t = v[r][j][h]; s += (t[0] * t[0] + t[1] * t[1]) + (t[2] * t[2] + t[3] * t[3]); }
            sq[r] = wave_sum(s);
            u32x4v* o16 = (u32x4v*)(XB + (size_t)(m + r * NGW) * DM) + lane;
#pragma unroll
            for (int j = 0; j < 2; ++j) { u32x4v w; w.x = pk2(v[r][j][0][0], v[r][j][0][1]); w.y = pk2(v[r][j][0][2], v[r][j][0][3]); w.z = pk2(v[r][j][1][0], v[r][j][1][1]); w.w = pk2(v[r][j][1][2], v[r][j][1][3]); o16[64 * j] = w; } }
        if (lane == 0) { ssq0[m] = sq[0]; ssq0[m + NGW] = sq[1]; }
    }
    const float* p = A.in[1]; bf16* PB = (bf16*)(ws + WS_PB);
    { const f32x4* p4 = (const f32x4*)p; u32x4v* o8 = (u32x4v*)PB; const int n8 = T_ROWS * PLE / 8, gt = gw * 64 + lane, GT = NGW * 64;
      for (int rp_ = 0; rp_ < (((PROBE_MASK) >> 25) & 1 ? 2 : 1); ++rp_)
      for (int i = gt; i < n8; i += 4 * GT) { f32x4 v[4][2];
#pragma unroll
          for (int j = 0; j < 4; ++j) { v[j][0] = p4[2 * (i + j * GT)]; v[j][1] = p4[2 * (i + j * GT) + 1]; }
#pragma unroll
          for (int j = 0; j < 4; ++j) { u32x4v w; w.x = pk2(v[j][0][0], v[j][0][1]); w.y = pk2(v[j][0][2], v[j][0][3]); w.z = pk2(v[j][1][0], v[j][1][1]); w.w = pk2(v[j][1][2], v[j][1][3]); o8[i + j * GT] = w; } } }
    float* cosT = (float*)(ws + WS_TAB); float* sinT = cosT + SEQ * 32;
    for (int e = (blockIdx.x * NWAVES + wave) * 64 + lane; e < SEQ * 32; e += gridDim.x * NWAVES * 64) { const int pos = e >> 5, i = e & 31;
        const float inv = exp2f(-(float)(2 * i) * (1.0f / 64.0f) * 13.287712379549449f);
        const float ang = (float)pos * inv; const double rev = (double)ang * 0.15915494309189535; const float fr = (float)(rev - __builtin_floor(rev));
        cosT[e] = __builtin_amdgcn_cosf(fr); sinT[e] = __builtin_amdgcn_sinf(fr); }
}

namespace swa {
typedef float f32x16 __attribute__((ext_vector_type(16)));
typedef short bf16x8 __attribute__((ext_vector_type(8)));
typedef short s16x4 __attribute__((ext_vector_type(4)));
typedef unsigned u32x4 __attribute__((ext_vector_type(4)));
constexpr int LK = 0, LV = 32768, LST = 65536, LWS = 98304, LDS_END = LWS + 8 * 256;
constexpr float LOG2E = 1.4426950408889634f;
__device__ __forceinline__ int crow(int r, int hi) { return (r & 3) + 8 * (r >> 2) + 4 * hi; }
__device__ __forceinline__ s16x4 vtr(LAS const unsigned char* p) { return __builtin_bit_cast(s16x4, __builtin_amdgcn_ds_read_tr16_b64_v4i16((LAS s16x4*)p)); }
__device__ __forceinline__ unsigned cvtpk(float lo, float hi) { typedef float f2 __attribute__((ext_vector_type(2))); typedef __bf16 b2 __attribute__((ext_vector_type(2))); f2 v = {lo, hi}; b2 b = __builtin_convertvector(v, b2); return __builtin_bit_cast(unsigned, b); }
__device__ __forceinline__ float xhalf_max(float m) { auto rr = __builtin_amdgcn_permlane32_swap(__float_as_uint(m), __float_as_uint(m), false, false); return fmaxf(__uint_as_float(rr[0]), __uint_as_float(rr[1])); }
__device__ __forceinline__ float xhalf_sum(float m) { auto rr = __builtin_amdgcn_permlane32_swap(__float_as_uint(m), __float_as_uint(m), false, false); return __uint_as_float(rr[0]) + __uint_as_float(rr[1]); }

struct KVRegs { u32x4 k[4], v[4]; };
__device__ __forceinline__ void kv_load(KVRegs& R, const bf16* Z, int u) {
    const int tid = threadIdx.x, n = u & 31, kvh = (u >> 5) & 1, b = u >> 6; const long rowb = (long)b * SEQ + (long)(n - 1) * 128;
#pragma unroll
    for (int i = 0; i < 4; ++i) { const int e = tid + 512 * i, key = e >> 3, c = e & 7; R.k[i] = (u32x4){0u, 0u, 0u, 0u}; R.v[i] = R.k[i];
        if (n > 0 || key >= 128) { const bf16* rp = Z + pg8::zoff((int)(rowb + key)) + 64 * kvh + 8 * c; R.k[i] = *(const u32x4*)(rp + ZC_AK); R.v[i] = *(const u32x4*)(rp + ZC_AV); } }
}
__device__ __forceinline__ void attn_phase(const bf16* Z, bf16* MIX, const float* sinks, LAS unsigned char* lds) {
    const int tid = threadIdx.x, lane = tid & 63, l31 = lane & 31, hi = lane >> 5, wave = __builtin_amdgcn_readfirstlane(tid >> 6), G = gridDim.x;
    LAS float* wsf = (LAS float*)(lds + LWS + wave * 256); LAS unsigned short* stg = (LAS unsigned short*)(lds + LST + wave * 4096);
    const int kswz = (l31 >> 1) & 7, g = wave >> 1, s = wave & 1;
    LAS const unsigned char* vbase = lds + LV + (4 * hi + ((lane & 15) >> 2)) * 64 + (16 * ((lane >> 4) & 1) + 4 * (lane & 3)) * 2;
    const int ub = (int)(blockIdx.x & 7) * 64, ui0 = (int)(blockIdx.x >> 3), UI = G >> 3;
    int ui = ui0; KVRegs kv; if (ui < 64) kv_load(kv, Z, ub + ui);
#pragma unroll 1
    for (; ui < 64; ui += UI) { const int u = ub + ui, n = u & 31, kvh = (u >> 5) & 1, b = u >> 6, head = 4 * kvh + g;
#pragma unroll
        for (int i = 0; i < 4; ++i) { const int e = tid + 512 * i, key = e >> 3, c = e & 7;
            *(LAS u32x4*)(lds + LK + key * 128 + ((c ^ ((key >> 1) & 7)) << 4)) = kv.k[i];
            *(LAS u32x4*)(lds + LV + (c >> 2) * 16384 + key * 64 + (c & 3) * 16) = kv.v[i]; }
        const size_t qrowb = (size_t)b * SEQ + (size_t)n * 128 + 64 * s;
        bf16x8 qn[4];
#pragma unroll
        for (int ks = 0; ks < 4; ++ks) qn[ks] = *(const bf16x8*)(Z + pg8::zoff((int)(qrowb + l31)) + ZC_AQ + 64 * head + 16 * ks + 8 * hi);
        const float sink2 = sinks[head] * LOG2E;
        { const int uin = ui + UI; if (uin < 64) kv_load(kv, Z, ub + uin); }
        __syncthreads();
#pragma unroll 1
        for (int qb2 = 0; qb2 < 2; ++qb2) {
            const int kb0 = 2 * s + qb2, qi0 = 32 * kb0; const size_t qrow0 = qrowb + 32 * qb2;
            bf16x8 qf[4];
#pragma unroll
            for (int ks = 0; ks < 4; ++ks) qf[ks] = qn[ks];
            if (qb2 == 0) {
#pragma unroll
                for (int ks = 0; ks < 4; ++ks) qn[ks] = *(const bf16x8*)(Z + pg8::zoff((int)(qrowb + 32 + l31)) + ZC_AQ + 64 * head + 16 * ks + 8 * hi); }
            f32x16 st[5];
#pragma unroll
            for (int kb = 0; kb < 5; ++kb) { st[kb] = (f32x16){};
#pragma unroll
                for (int ks = 0; ks < 4; ++ks) { const bf16x8 kf = *(LAS const bf16x8*)(lds + LK + (32 * (kb0 + kb) + l31) * 128 + (((2 * ks + hi) ^ kswz) << 4));
                    st[kb] = __builtin_amdgcn_mfma_f32_32x32x16_bf16(kf, qf[ks], st[kb], 0, 0, 0); } }
            float mx = sink2;
#pragma unroll
            for (int kb = 0; kb < 5; ++kb)
#pragma unroll
                for (int r = 0; r < 16; ++r) { const int cr = crow(r, hi); bool valid = true;
                    if (kb == 0) valid = cr > l31; if (kb == 4) valid = cr <= l31;
                    if (kb == 0 || kb == 4) st[kb][r] = valid ? st[kb][r] : -INFINITY; }
            if (n == 0) {
#pragma unroll
                for (int kb = 0; kb < 5; ++kb)
#pragma unroll
                    for (int r = 0; r < 16; ++r) st[kb][r] = (qi0 + 32 * kb + crow(r, hi) >= 128) ? st[kb][r] : -INFINITY; }
#pragma unroll
            for (int kb = 0; kb < 5; ++kb)
#pragma unroll
                for (int r = 0; r < 16; ++r) { mx = fmaxf(mx, st[kb][r]); }
            mx = xhalf_max(mx);
            float l;
            { const float nmx = -mx; f32x16 ls = (f32x16){};
#pragma unroll
              for (int kb = 0; kb < 5; ++kb) { f32x16 t = st[kb] + nmx;
#pragma unroll
                  for (int r = 0; r < 16; ++r) t[r] = __builtin_amdgcn_exp2f(t[r]);
                  st[kb] = t; ls += t; }
              typedef float f32x8 __attribute__((ext_vector_type(8))); typedef float f32x4a __attribute__((ext_vector_type(4))); typedef float f32x2a __attribute__((ext_vector_type(2)));
              const f32x8 a8 = ls.lo + ls.hi; const f32x4a a4 = a8.lo + a8.hi; const f32x2a a2 = a4.lo + a4.hi; l = a2[0] + a2[1]; }
            l = xhalf_sum(l) + __builtin_amdgcn_exp2f(sink2 - mx);
            f32x16 o[2]; o[0] = (f32x16){}; o[1] = (f32x16){};
#pragma unroll
            for (int kb = 0; kb < 5; ++kb)
#pragma unroll
                for (int s2 = 0; s2 < 2; ++s2) { u32x4 pw; pw.x = cvtpk(st[kb][8 * s2 + 0], st[kb][8 * s2 + 1]); pw.y = cvtpk(st[kb][8 * s2 + 2], st[kb][8 * s2 + 3]); pw.z = cvtpk(st[kb][8 * s2 + 4], st[kb][8 * s2 + 5]); pw.w = cvtpk(st[kb][8 * s2 + 6], st[kb][8 * s2 + 7]);
                    const bf16x8 pa = __builtin_bit_cast(bf16x8, pw); const int key0 = 32 * (kb0 + kb) + 16 * s2;
#pragma unroll
                    for (int d0 = 0; d0 < 2; ++d0) { const s16x4 lo = vtr(vbase + d0 * 16384 + key0 * 64), hh = vtr(vbase + d0 * 16384 + (key0 + 8) * 64);
                        const bf16x8 vb = {lo[0], lo[1], lo[2], lo[3], hh[0], hh[1], hh[2], hh[3]};
                        o[d0] = __builtin_amdgcn_mfma_f32_32x32x16_bf16(vb, pa, o[d0], 0, 0, 0); } }
            { const float il = __builtin_amdgcn_rcpf(l); LAS unsigned char* stgb = (LAS unsigned char*)stg;
#pragma unroll
              for (int d0 = 0; d0 < 2; ++d0)
#pragma unroll
                  for (int g4 = 0; g4 < 4; ++g4) { const f32x4 t = (f32x4){o[d0][4 * g4], o[d0][4 * g4 + 1], o[d0][4 * g4 + 2], o[d0][4 * g4 + 3]} * il;
                      u32x2v w; w.x = cvtpk(t[0], t[1]); w.y = cvtpk(t[2], t[3]);
                      *(LAS u32x2v*)(stgb + l31 * 128 + (((4 * d0 + g4) ^ (l31 & 7)) << 4) + 8 * hi) = w; }
              asm volatile("s_waitcnt lgkmcnt(0)" ::: "memory");
#pragma unroll
              for (int i = 0; i < 4; ++i) { const int row = i * 8 + (lane >> 3), ch = lane & 7; const u32x4 v = *(LAS const u32x4*)(stgb + row * 128 + ((ch ^ (row & 7)) << 4));
                  *(u32x4*)(MIX + (qrow0 + row) * DM + 64 * head + ch * 8) = v; } }
            asm volatile("s_waitcnt lgkmcnt(0)" ::: "memory");
        }
        __syncthreads();
    }
}
}
namespace gla {
typedef float f32x16 __attribute__((ext_vector_type(16)));
typedef short bf16x8 __attribute__((ext_vector_type(8)));
typedef short s16x4 __attribute__((ext_vector_type(4)));
typedef unsigned u32x4 __attribute__((ext_vector_type(4)));
typedef unsigned u32x2 __attribute__((ext_vector_type(2)));
constexpr int GL_GLR = 0, GL_WU = 4096, GL_BIAS = 8192, GL_SEG = 8448, GL_B = 10496, GL_QT = 26880, GL_KT = 35072, GL_KH = 43264, GL_V = 51456, GL_S = 67840, GL_RS = 84224, GL_STG = 85248, STG_LD = 132, GL_END = GL_STG + 64 * STG_LD * 4;
static_assert(GL_END <= 131072, "GLA LDS map");
constexpr float LOG2E = 1.4426950408889634f;
__device__ __forceinline__ int crow(int r, int hi) { return (r & 3) + 8 * (r >> 2) + 4 * hi; }
__device__ __forceinline__ s16x4 vtr(LAS const unsigned char* p) { return __builtin_bit_cast(s16x4, __builtin_amdgcn_ds_read_tr16_b64_v4i16((LAS s16x4*)p)); }
__device__ __forceinline__ bf16x8 tr2(LAS const unsigned char* p, int second_off) { const s16x4 a = vtr(p), b = vtr(p + second_off); return (bf16x8){a[0], a[1], a[2], a[3], b[0], b[1], b[2], b[3]}; }
__device__ __forceinline__ unsigned cvtpk(float lo, float hi) { typedef float f2 __attribute__((ext_vector_type(2))); typedef __bf16 b2 __attribute__((ext_vector_type(2))); f2 v = {lo, hi}; b2 b = __builtin_convertvector(v, b2); return __builtin_bit_cast(unsigned, b); }
__device__ __forceinline__ float xhalf_sum(float m) { auto rr = __builtin_amdgcn_permlane32_swap(__float_as_uint(m), __float_as_uint(m), false, false); return __uint_as_float(rr[0]) + __uint_as_float(rr[1]); }
__device__ __forceinline__ float bflo(unsigned w) { return __uint_as_float(w << 16); }
__device__ __forceinline__ float bfhi(unsigned w) { return __uint_as_float(w & 0xffff0000u); }

__device__ __forceinline__ size_t bt_off(int u) { return (size_t)(u >> 8) * (4096 * 1024) + (size_t)(u & 255) * 4096; }
__device__ __forceinline__ size_t gg_off(int g) { return (size_t)(g >> 5) * (4096 * 1024) + (size_t)256 * 4096 + (size_t)(g & 31) * 8192; }
__device__ __forceinline__ void gates(LAS unsigned char* lds, const float (&wcol)[16], float bz) {
    const int tid = threadIdx.x;
    LAS float* gl = (LAS float*)(lds + GL_GLR); LAS float* seg = (LAS float*)(lds + GL_SEG); LAS float* bt = (LAS float*)(lds + GL_B);
    const int dk = tid & 63, sg = tid >> 6; float run = 0.f, cs[8];
#pragma unroll
    for (int i = 0; i < 8; ++i) { const int tok = 8 * sg + i; float z = bz;
#pragma unroll
        for (int r = 0; r < 16; ++r) z += gl[tok * 16 + r] * wcol[r];
        const float e = __builtin_amdgcn_exp2f(-fabsf(z) * LOG2E);
        const float g2 = (fminf(z, 0.f) * LOG2E - __builtin_amdgcn_logf(1.0f + e)) * (1.0f / 16.0f);
        run += g2; cs[i] = run; }
    seg[sg * 64 + dk] = run;
    __syncthreads();
    float off = 0.f;
#pragma unroll
    for (int s = 0; s < 8; ++s) off += (s < sg) ? seg[s * 64 + dk] : 0.f;
#pragma unroll
    for (int i = 0; i < 8; ++i) bt[(8 * sg + i) * 64 + dk] = cs[i] + off;
    __syncthreads();
}
__device__ __forceinline__ void load_wcol(const float* Wup, const float* bgate, int hh, float (&wcol)[16], float& bz) {
    const int dk = threadIdx.x & 63;
#pragma unroll
    for (int r = 0; r < 16; ++r) wcol[r] = Wup[r * 256 + 64 * hh + dk];
    bz = bgate[64 * hh + dk];
}
struct ChunkRegs { u32x4 kw, qw, v[2], gog[2]; f32x4 s[4], b0, b1; unsigned glr; float dec; };
template <bool P3> __device__ __forceinline__ void chunk_load(ChunkRegs& R, const bf16* Z, const float* GS, const float* DEC_, const float* BT, int u) {
    const int tid = threadIdx.x, bh = u >> 6, c = u & 63, hh = bh & 3, row0 = (bh >> 2) * SEQ + c * 64, tok = tid >> 3, ch = tid & 7;
    const bf16* zr = Z + pg8::zoff(row0 + tok);
    R.kw = *(const u32x4*)(zr + ZC_GK + 64 * hh + 8 * ch);
    if (!P3) R.glr = *(const unsigned*)(zr + ZC_GLR + 2 * ch);
    if (P3) { R.qw = *(const u32x4*)(zr + ZC_GQ + 64 * hh + 8 * ch); const f32x4* bp = (const f32x4*)(BT + bt_off(u) + tok * 64 + 8 * ch); R.b0 = bp[0]; R.b1 = bp[1]; }
#pragma unroll
    for (int i = 0; i < 2; ++i) { const int e = tid + 512 * i, tk = e >> 4, cc = e & 15; R.v[i] = *(const u32x4*)(Z + pg8::zoff(row0 + tk) + ZC_GV + 128 * hh + 8 * cc);
        if (P3) R.gog[i] = *(const u32x4*)(Z + pg8::zoff(row0 + tk) + ZC_GOG + 128 * hh + 8 * cc); }
    if (P3) {
#pragma unroll
        for (int i = 0; i < 4; ++i) R.s[i] = *(const f32x4*)(GS + (size_t)u * 8192 + (tid >> 3) * 128 + (tid & 7) * 16 + 4 * i);
        R.dec = DEC_[(size_t)u * 64 + (tid >> 3)]; }
}
template <bool P3> __device__ __forceinline__ void chunk_stage(const ChunkRegs& R, LAS unsigned char* lds) {
    const int tid = threadIdx.x; LAS float* gl = (LAS float*)(lds + GL_GLR);
    if (!P3) { gl[(tid >> 3) * 16 + (tid & 7) * 2] = bflo(R.glr); gl[(tid >> 3) * 16 + (tid & 7) * 2 + 1] = bfhi(R.glr); }
#pragma unroll
    for (int i = 0; i < 2; ++i) { const int e = tid + 512 * i, tk = e >> 4, cc = e & 15; *(LAS u32x4*)(lds + GL_V + (cc >> 2) * 4096 + tk * 64 + (cc & 3) * 16) = R.v[i]; }
}
__device__ __forceinline__ void passA(const Args& A, LAS unsigned char* lds) {
    const bf16* Z = (const bf16*)(A.ws + WS_ACT); float* DEC = (float*)(A.ws + WS_DEC); float* AG = (float*)(A.ws + WS_AG); float* GS = (float*)(A.ws + WS_GS); float* BT = A.out; float* GG = A.out;
    const int tid = threadIdx.x, lane = tid & 63, l31 = lane & 31, hi = lane >> 5, wave = __builtin_amdgcn_readfirstlane(tid >> 6), G = gridDim.x;
    LAS float* bt = (LAS float*)(lds + GL_B);
    const int troff = (8 * hi + ((lane & 15) >> 2)) * 64 + (16 * ((lane >> 4) & 1) + 4 * (lane & 3)) * 2;
    const int dkb = wave & 1, db = wave >> 1, tok = tid >> 3, ch = tid & 7;
    float wcol[16], bz = 0.f; int hprev = -1;
    const int gb = (int)(blockIdx.x & 7) * 32, GI = G >> 3; int gi = (int)(blockIdx.x >> 3); ChunkRegs cur; if (gi < 32) chunk_load<false>(cur, Z, GS, DEC, BT, (gb + gi) * 8);
#pragma unroll 1
    for (; gi < 32; gi += GI) { const int g = gb + gi, hh = (g >> 3) & 3;
        if (hh != hprev) { load_wcol(A.in[11], A.in[12], hh, wcol, bz); hprev = hh; }
        f32x16 gacc = (f32x16){}; float bsum = 0.f;
#pragma unroll 1
        for (int j = 0; j < 8; ++j) { const int u = g * 8 + j;
            chunk_stage<false>(cur, lds);
            const u32x4 kw = cur.kw;
            { const int un = (j < 7) ? u + 1 : ((gi + GI < 32) ? (g + GI) * 8 : 2048); if (un < 2048) chunk_load<false>(cur, Z, GS, DEC, BT, un); }
            __syncthreads();
            gates(lds, wcol, bz);
            if (tid < 64) { const float bl = bt[63 * 64 + tid]; DEC[(size_t)u * 64 + tid] = __builtin_amdgcn_exp2f(bl); bsum += bl; }
            { const f32x4 b0 = *(LAS const f32x4*)(bt + tok * 64 + 8 * ch), b1 = *(LAS const f32x4*)(bt + tok * 64 + 8 * ch + 4), l0 = *(LAS const f32x4*)(bt + 63 * 64 + 8 * ch), l1 = *(LAS const f32x4*)(bt + 63 * 64 + 8 * ch + 4);
              { f32x4* bp = (f32x4*)(BT + bt_off(u) + tok * 64 + 8 * ch); bp[0] = b0; bp[1] = b1; }
              u32x4 o; o.x = cvtpk(bflo(kw.x) * __builtin_amdgcn_exp2f(l0[0] - b0[0]), bfhi(kw.x) * __builtin_amdgcn_exp2f(l0[1] - b0[1])); o.y = cvtpk(bflo(kw.y) * __builtin_amdgcn_exp2f(l0[2] - b0[2]), bfhi(kw.y) * __builtin_amdgcn_exp2f(l0[3] - b0[3]));
              o.z = cvtpk(bflo(kw.z) * __builtin_amdgcn_exp2f(l1[0] - b1[0]), bfhi(kw.z) * __builtin_amdgcn_exp2f(l1[1] - b1[1])); o.w = cvtpk(bflo(kw.w) * __builtin_amdgcn_exp2f(l1[2] - b1[2]), bfhi(kw.w) * __builtin_amdgcn_exp2f(l1[3] - b1[3]));
              *(LAS u32x4*)(lds + GL_KH + (ch >> 2) * 4096 + tok * 64 + (ch & 3) * 16) = o; }
            __syncthreads();
            f32x16 acc = (f32x16){};
#pragma unroll
            for (int ks = 0; ks < 4; ++ks) { const bf16x8 a = tr2(lds + GL_KH + dkb * 4096 + ks * 1024 + troff, 256), b = tr2(lds + GL_V + db * 4096 + ks * 1024 + troff, 256);
                acc = __builtin_amdgcn_mfma_f32_32x32x16_bf16(a, b, acc, 0, 0, 0); }
            float* gp = GS + (size_t)u * 8192 + 32 * db + l31;
#pragma unroll
            for (int r = 0; r < 16; ++r) { const int dk = 32 * dkb + crow(r, hi); gp[dk * 128] = acc[r]; gacc[r] = __builtin_amdgcn_exp2f(bt[63 * 64 + dk]) * gacc[r] + acc[r]; }
            __syncthreads(); }
        float* gq = GG + gg_off(g) + 32 * db + l31;
#pragma unroll
        for (int r = 0; r < 16; ++r) gq[(32 * dkb + crow(r, hi)) * 128] = gacc[r];
        if (tid < 64) AG[(size_t)g * 64 + tid] = __builtin_amdgcn_exp2f(bsum); }
}
__device__ __forceinline__ void passB(const Args& A, LAS unsigned char* lds) {
    const bf16* Z = (const bf16*)(A.ws + WS_ACT); bf16* MIX = (bf16*)(A.ws + WS_MIX); const float* GS = (const float*)(A.ws + WS_GS); const float* gon = A.in[13];
    const float* DEC = (const float*)(A.ws + WS_DEC); const float* AG = (const float*)(A.ws + WS_AG); const float* BT = A.out; const float* GG = A.out;
    const int tid = threadIdx.x, lane = tid & 63, l31 = lane & 31, hi = lane >> 5, wave = __builtin_amdgcn_readfirstlane(tid >> 6), G = gridDim.x;
    LAS float* rs = (LAS float*)(lds + GL_RS); LAS float* stg = (LAS float*)(lds + GL_STG);
    const int trcol = (16 * ((lane >> 4) & 1) + 4 * (lane & 3)) * 2, trq = (lane & 15) >> 2;
    const int troff_nat = (8 * hi + trq) * 64 + trcol;
    const int troff_acc = (4 * hi + trq) * 64 + trcol;
    const int tok = tid >> 3, ch = tid & 7;
    const int gb = (int)(blockIdx.x & 7) * 32, GI = G >> 3; int gi = (int)(blockIdx.x >> 3); ChunkRegs cur; if (gi < 32) chunk_load<true>(cur, Z, GS, DEC, BT, (gb + gi) * 8);
#pragma unroll 1
    for (; gi < 32; gi += GI) { const int g = gb + gi;
      f32x4 S[4]; S[0] = S[1] = S[2] = S[3] = (f32x4){0.f, 0.f, 0.f, 0.f};
      { const int gfirst = g & ~7;
#pragma unroll 1
        for (int g2 = gfirst; g2 < g; ++g2) { const float a = AG[(size_t)g2 * 64 + tok]; const f32x4* gp = (const f32x4*)(GG + gg_off(g2) + tok * 128 + ch * 16);
#pragma unroll
            for (int i = 0; i < 4; ++i) S[i] = S[i] * a + gp[i]; } }
#pragma unroll 1
      for (int j = 0; j < 8; ++j) { const int u = g * 8 + j, bh = u >> 6, c = u & 63, hh = bh & 3, row0 = (bh >> 2) * SEQ + c * 64;
        chunk_stage<true>(cur, lds);
        { u32x4 w0, w1; w0.x = cvtpk(S[0][0], S[0][1]); w0.y = cvtpk(S[0][2], S[0][3]); w0.z = cvtpk(S[1][0], S[1][1]); w0.w = cvtpk(S[1][2], S[1][3]); w1.x = cvtpk(S[2][0], S[2][1]); w1.y = cvtpk(S[2][2], S[2][3]); w1.z = cvtpk(S[3][0], S[3][1]); w1.w = cvtpk(S[3][2], S[3][3]);
          LAS unsigned char* sp = lds + GL_S + (ch >> 1) * 4096 + tok * 64 + (ch & 1) * 32; *(LAS u32x4*)sp = w0; *(LAS u32x4*)(sp + 16) = w1; }
        const u32x4 kw = cur.kw, qw = cur.qw, gog0 = cur.gog[0], gog1 = cur.gog[1]; const f32x4 b0 = cur.b0, b1 = cur.b1;
#pragma unroll
        for (int i = 0; i < 4; ++i) S[i] = S[i] * cur.dec + cur.s[i];
        { const int un = (j < 7) ? u + 1 : ((gi + GI < 32) ? (g + GI) * 8 : 2048); if (un < 2048) chunk_load<true>(cur, Z, GS, DEC, BT, un); }
        { float ep[8], em[8];
#pragma unroll
          for (int j = 0; j < 4; ++j) { ep[j] = __builtin_amdgcn_exp2f(b0[j]); ep[4 + j] = __builtin_amdgcn_exp2f(b1[j]); em[j] = __builtin_amdgcn_exp2f(-b0[j]); em[4 + j] = __builtin_amdgcn_exp2f(-b1[j]); }
          u32x4 oq, ok; oq.x = cvtpk(bflo(qw.x) * ep[0], bfhi(qw.x) * ep[1]); oq.y = cvtpk(bflo(qw.y) * ep[2], bfhi(qw.y) * ep[3]); oq.z = cvtpk(bflo(qw.z) * ep[4], bfhi(qw.z) * ep[5]); oq.w = cvtpk(bflo(qw.w) * ep[6], bfhi(qw.w) * ep[7]);
          ok.x = cvtpk(bflo(kw.x) * em[0], bfhi(kw.x) * em[1]); ok.y = cvtpk(bflo(kw.y) * em[2], bfhi(kw.y) * em[3]); ok.z = cvtpk(bflo(kw.z) * em[4], bfhi(kw.z) * em[5]); ok.w = cvtpk(bflo(kw.w) * em[6], bfhi(kw.w) * em[7]);
          const int sw = (ch ^ ((tok >> 1) & 7)) << 4;
          *(LAS u32x4*)(lds + GL_QT + tok * 128 + sw) = oq; *(LAS u32x4*)(lds + GL_KT + tok * 128 + sw) = ok; }
        __syncthreads();
        const int ib = wave & 1, db = wave >> 1, kswz = (l31 >> 1) & 7;
        bf16x8 qb[4];
#pragma unroll
        for (int ks = 0; ks < 4; ++ks) qb[ks] = *(LAS const bf16x8*)(lds + GL_QT + (32 * ib + l31) * 128 + (((2 * ks + hi) ^ kswz) << 4));
        f32x16 o = (f32x16){};
#pragma unroll
        for (int jb = 0; jb < 2; ++jb) { if (jb <= ib) {
            f32x16 x = (f32x16){};
#pragma unroll
            for (int ks = 0; ks < 4; ++ks) { const bf16x8 kf = *(LAS const bf16x8*)(lds + GL_KT + (32 * jb + l31) * 128 + (((2 * ks + hi) ^ kswz) << 4)); x = __builtin_amdgcn_mfma_f32_32x32x16_bf16(kf, qb[ks], x, 0, 0, 0); }
            if (jb == ib) {
#pragma unroll
                for (int r = 0; r < 16; ++r) x[r] = (crow(r, hi) <= l31) ? x[r] : 0.f; }
#pragma unroll
            for (int s2 = 0; s2 < 2; ++s2) { u32x4 pw; pw.x = cvtpk(x[8 * s2 + 0], x[8 * s2 + 1]); pw.y = cvtpk(x[8 * s2 + 2], x[8 * s2 + 3]); pw.z = cvtpk(x[8 * s2 + 4], x[8 * s2 + 5]); pw.w = cvtpk(x[8 * s2 + 6], x[8 * s2 + 7]);
                const bf16x8 va = tr2(lds + GL_V + db * 4096 + (32 * jb + 16 * s2) * 64 + troff_acc, 512);
                o = __builtin_amdgcn_mfma_f32_32x32x16_bf16(va, __builtin_bit_cast(bf16x8, pw), o, 0, 0, 0); } } }
#pragma unroll
        for (int ks = 0; ks < 4; ++ks) { const bf16x8 sa = tr2(lds + GL_S + db * 4096 + ks * 1024 + troff_nat, 256); o = __builtin_amdgcn_mfma_f32_32x32x16_bf16(sa, qb[ks], o, 0, 0, 0); }
        float ss = 0.f;
#pragma unroll
        for (int r = 0; r < 16; ++r) ss += o[r] * o[r];
        ss = xhalf_sum(ss);
        if (hi == 0) rs[db * 64 + 32 * ib + l31] = ss;
#pragma unroll
        for (int r4 = 0; r4 < 4; ++r4) *(LAS f32x4*)(stg + (32 * ib + l31) * STG_LD + 32 * db + 8 * r4 + 4 * hi) = (f32x4){o[4 * r4], o[4 * r4 + 1], o[4 * r4 + 2], o[4 * r4 + 3]};
        __syncthreads();
#pragma unroll
        for (int i = 0; i < 2; ++i) { const int e = tid + 512 * i, tk = e >> 4, cc = e & 15, dv0 = 8 * cc;
            const float rn = __builtin_amdgcn_rsqf(((rs[tk] + rs[64 + tk]) + (rs[128 + tk] + rs[192 + tk])) * (1.0f / 128.0f) + 1e-6f);
            const f32x4 o0 = *(LAS const f32x4*)(stg + tk * STG_LD + dv0), o1 = *(LAS const f32x4*)(stg + tk * STG_LD + dv0 + 4);
            const u32x4 gw = i ? gog1 : gog0; const f32x4 n0 = *(const f32x4*)(gon + dv0), n1 = *(const f32x4*)(gon + dv0 + 4);
            const float g[8] = {bflo(gw.x), bfhi(gw.x), bflo(gw.y), bfhi(gw.y), bflo(gw.z), bfhi(gw.z), bflo(gw.w), bfhi(gw.w)}; float y[8];
#pragma unroll
            for (int j = 0; j < 8; ++j) { const float ov = (j < 4 ? o0[j & 3] : o1[j & 3]), nv = (j < 4 ? n0[j & 3] : n1[j & 3]); y[j] = ov * rn * nv * (g[j] * __builtin_amdgcn_rcpf(1.0f + __builtin_amdgcn_exp2f(-g[j] * LOG2E))); }
            u32x4 w; w.x = cvtpk(y[0], y[1]); w.y = cvtpk(y[2], y[3]); w.z = cvtpk(y[4], y[5]); w.w = cvtpk(y[6], y[7]);
            *(u32x4*)(MIX + (size_t)(row0 + tk) * DM + 512 + 128 * hh + dv0) = w; }
        __syncthreads(); } }
}
}
#ifndef PROBE_MASK
#define PROBE_MASK 0
#endif
struct FastOrder : pg8::StaticOrder { int fx, fj, per, nig;
    __device__ __forceinline__ void init(int M, int N, int G_, int c_) { pg8::StaticOrder::init(M, N, G_, c_); fx = c_ & 7; fj = c_ >> 3; per = (N / pg8::BM) >> 1; nig = 8 * (N / pg8::BM); }
    __device__ __forceinline__ bool next(int i, pg8::Unit& u) const { if (i >= per) return false; const int l = 32 * i + fj, grp = (l >= nig) ? 1 : 0, r = l - (grp ? nig : 0); u.pm = 16 * fx + 8 * grp + (r & 7); u.pn = r >> 3; u.aux = 0; return true; } };
struct RepOrder : FastOrder { int reps;
    __device__ __forceinline__ void init2(int M, int N, int G_, int c_, int reps_) { init(M, N, G_, c_); reps = reps_; }
    __device__ __forceinline__ bool next(int i, pg8::Unit& u) const {
#if PROBE_MASK
        if (i >= per * reps) return false; const int rep = (i >= 7 * per) ? 7 : (i >= 6 * per) ? 6 : (i >= 5 * per) ? 5 : (i >= 4 * per) ? 4 : (i >= 3 * per) ? 3 : (i >= 2 * per) ? 2 : (i >= per) ? 1 : 0;
        const bool ok = FastOrder::next(i - rep * per, u); u.aux = rep; return ok;
#else
        return FastOrder::next(i, u);
#endif
    } };
struct SameOrder : pg8::StaticOrder { int n;
    __device__ __forceinline__ bool next(int i, pg8::Unit& u) const { if (i >= n) return false; u.pm = 0; u.pn = 0; return true; } };
__device__ __forceinline__ void team_table(const float* ssq, int nslots, int key, LAS float* rt) { const int t = threadIdx.x; rt[t] = pg8::rstd_row(ssq, (key + 8 * (t >> 8)) * 256 + (t & 255), nslots, 1.0f / 1024.0f); }
struct PreSeam { unsigned* ctl; int key; unsigned target; bool rel; XcdBarrier bar; int kind;
    int xg; unsigned xtarget; bool xrel;
    const float* ssqA; int nA; LAS float* rtA; const float* ssqB; int nB; LAS float* rtB;
    __device__ __forceinline__ void operator()() const {
        if (kind == 4) hook_wait(ctl, key, target, CW_TEAM); else if (kind == 5) hook_wait(ctl, xg, xtarget, CW_XG); else if (kind == 2) xcd_barrier(bar); }
    __device__ __forceinline__ void post() const {
        if (ssqA) team_table(ssqA, nA, key, rtA);
        if (ssqB) team_table(ssqB, nB, key, rtB);
        if (ssqA) { asm volatile("s_waitcnt lgkmcnt(0)" ::: "memory"); } } };
struct SliceOrder : FastOrder { int i0, i1;
    __device__ __forceinline__ bool next(int i, pg8::Unit& u) const { if (i0 + i >= i1) return false; return FastOrder::next(i0 + i, u); } };
#define NREP(k) ((((PROBE_MASK) >> (k)) & 1) ? 2 : 1)
constexpr int N_PHASES = 10;
__global__ void __launch_bounds__(NWAVES * 64, 2) hymba_fwd(Args args) {
    extern __shared__ __attribute__((aligned(16))) unsigned char lds_raw[];
    LAS unsigned char* lds = (LAS unsigned char*)lds_raw;
    const int tid = threadIdx.x, lane = tid & 63, wave = __builtin_amdgcn_readfirstlane(tid >> 6);
    const int G = gridDim.x, lo = args.ph_lo, hi = args.ph_hi;
    unsigned char* ws = args.ws;
    if (tid < 4) ((LAS unsigned*)(lds + LDSCTL_OFF))[tid] = 0u;
    __syncthreads();
    XcdBarrier bar = xcd_barrier_post((unsigned*)(ws + WS_CTL), (volatile LAS unsigned*)(lds + LDSCTL_OFF));
    unsigned* ctl = (unsigned*)(ws + WS_CTL); int team_key; { pg8::StaticOrder S0; S0.init(T_ROWS, DM, G, (int)blockIdx.x); pg8::Unit u0; u0.pm = 0; u0.pn = 0; u0.aux = 0; (void)S0.next(0, u0); team_key = u0.pm & 127; }
    if (tid == 0) (void)__hip_atomic_fetch_or(ctl + CW_TMASK + 64 * team_key, 1u << xb_xcc_id(), __ATOMIC_RELAXED, __HIP_MEMORY_SCOPE_AGENT);
    const int xg = (int)(blockIdx.x & 7);
    if (tid == 0) (void)__hip_atomic_fetch_or(ctl + CW_XGMASK + 64 * xg, 1u << xb_xcc_id(), __ATOMIC_RELAXED, __HIP_MEMORY_SCOPE_AGENT);
    unsigned team_epoch = 0, xg_epoch = 0; bool team_rel = true, xg_rel = true;
    bf16* XB = (bf16*)(ws + WS_XB); bf16* ACT = (bf16*)(ws + WS_ACT); bf16* MIX = (bf16*)(ws + WS_MIX); bf16* EMB = (bf16*)(ws + WS_EMB); bf16* PB = (bf16*)(ws + WS_PB);
    float* SSQ0 = (float*)(ws + WS_SSQ); float* SSQ1 = SSQ0 + (size_t)T_ROWS * 16; float* SSQ2 = SSQ1 + (size_t)T_ROWS * 16; float* SSQ3 = SSQ2 + (size_t)T_ROWS * 16; float* SSQ4 = SSQ3 + (size_t)T_ROWS * 16;
    const float* cosT = (const float*)(ws + WS_TAB); const float* sinT = cosT + SEQ * 32;
#ifndef PROBE_REPS
#define PROBE_REPS 2
#endif
#define REPS(k) for (int rep_ = 0; rep_ < (((PROBE_MASK) >> (k)) & 1 ? PROBE_REPS : 1); ++rep_)
#define IN(k) (lo <= (k) && (k) < hi)
#define SEAM(k) do { if (IN(k) && IN((k) + 1)) { xcd_barrier(bar); if ((PROBE_MASK >> 20) & 1) xcd_barrier(bar); } } while (0)
#define XSEAM(k) do { if (IN(k) && IN((k) + 1)) { xg_epoch += (unsigned)(G >> 3); team_barrier(ctl, xg, xg_epoch, xg_rel, CW_XG); } } while (0)
#define TSEAM(k) do { if (IN(k) && IN((k) + 1)) { team_epoch += 4u; team_barrier(ctl, team_key, team_epoch, team_rel); } } while (0)
    if (IN(0)) REPS(0) { phase_prologue(args, lds, wave, lane); __syncthreads(); } SEAM(0);
    if (IN(0) && IN(1)) { team_rel = __builtin_popcount(__hip_atomic_load(ctl + CW_TMASK + 64 * team_key, __ATOMIC_RELAXED, __HIP_MEMORY_SCOPE_AGENT)) != 1;
        if ((PROBE_MASK >> 27) & 1) team_rel = true;
        xg_rel = ((PROBE_MASK >> 27) & 1) ? true : ((PROBE_MASK >> 21) & 1) ? false : __builtin_popcount(__hip_atomic_load(ctl + CW_XGMASK + 64 * xg, __ATOMIC_RELAXED, __HIP_MEMORY_SCOPE_AGENT)) != 1; }
    LAS float* rt = (LAS float*)(lds + LDSCTL_OFF + 64);
    const int k8 = team_key + 8;
    PreSeam pre{ctl, team_key, 0u, team_rel, bar, 0, xg, 0u, xg_rel, nullptr, 0, rt, nullptr, 0, rt + 1024};
#ifndef EMB_MODE
#define EMB_MODE 1
#endif
#define RUN_EMB(i0_, i1_) do { pg8::Gemm g_{PB, (const bf16*)(ws + W_PP), T_ROWS, DM, PLE}; SliceOrder S_; S_.init(T_ROWS, DM, G, (int)blockIdx.x); S_.i0 = (i0_); S_.i1 = (i1_); \
        pg8::EpiEmb E_{EMB, SSQ4}; pg8::gemm_phase<pg8::EpiEmb, SliceOrder, true, true>(lds, g_, S_, E_); } while (0)
    if (IN(1)) {
        if ((xg & 1) && EMB_MODE == 4) RUN_EMB(0, 2);
        if ((xg & 1) && EMB_MODE == 5) RUN_EMB(0, 1);
        { pg8::Gemm g{XB, (const bf16*)(ws + W_1GU), T_ROWS, NGU, DM}; RepOrder S; S.init2(T_ROWS, NGU, G, (int)blockIdx.x, NREP(1));
          PreSeam p1 = pre; p1.kind = 0; p1.ssqA = SSQ0; p1.nA = 1;
          pg8::EpiSwiGLU E{ACT, FF, rt, k8, -1, -1}; pg8::gemm_phase<pg8::EpiSwiGLU, RepOrder, true, true, PreSeam>(lds, g, S, E, p1); }
#if (PROBE_MASK >> 16) & 1
        { pg8::Gemm g{XB, (const bf16*)(ws + W_1GU), T_ROWS, NGU, DM}; RepOrder S; S.init2(T_ROWS, NGU, G, (int)blockIdx.x, 1);
          pg8::EpiNone E{}; pg8::gemm_phase<pg8::EpiNone, RepOrder, true, true>(lds, g, S, E); }
#endif
#if (PROBE_MASK >> 22) & 1
        { pg8::Gemm g{(const bf16*)(ws + WS_GS), (const bf16*)(ws + WS_GS), T_ROWS, NGU, DM}; RepOrder S; S.init2(T_ROWS, NGU, G, (int)blockIdx.x, 1);
          pg8::EpiNone E{}; pg8::gemm_phase<pg8::EpiNone, RepOrder, true, true>(lds, g, S, E); }
#endif
        if ((xg & 1) && EMB_MODE >= 1) group_arrive(ctl, team_key, team_rel, CW_TEAM);
        if ((xg & 1) && EMB_MODE != 4) RUN_EMB(EMB_MODE == 5 ? 1 : 0, 2);
    }
    if (IN(2)) { pg8::Gemm g{ACT, (const bf16*)(ws + W_1D), T_ROWS, DM, FF}; RepOrder S; S.init2(T_ROWS, DM, G, (int)blockIdx.x, NREP(2));
        team_epoch += 4u; if (!((xg & 1) && EMB_MODE >= 1)) group_arrive(ctl, team_key, team_rel, CW_TEAM); PreSeam p2 = pre; p2.kind = 4; p2.target = team_epoch;
        pg8::EpiResid E{XB, SSQ1, 0.5f}; pg8::gemm_phase<pg8::EpiResid, RepOrder, false, true, PreSeam>(lds, g, S, E, p2); }
    if (IN(3)) { pg8::Gemm g{XB, (const bf16*)(ws + W_IN), T_ROWS, NIN, DM}; RepOrder S; S.init2(T_ROWS, NIN, G, (int)blockIdx.x, NREP(3));
        team_epoch += 4u; group_arrive(ctl, team_key, team_rel, CW_TEAM); PreSeam p3 = pre; p3.kind = 4; p3.target = team_epoch; p3.ssqA = SSQ1; p3.nA = 16;
        pg8::EpiZ E{ACT, rt, k8, -1, -1, cosT, sinT, args.in[8], args.in[9]}; pg8::gemm_phase<pg8::EpiZ, RepOrder, true, true, PreSeam>(lds, g, S, E, p3); } XSEAM(3);
    if (IN(4)) { REPS(12) gla::passA(args, lds); xg_epoch += (unsigned)(G >> 3); group_arrive(ctl, xg, xg_rel, CW_XG); REPS(4) swa::attn_phase(ACT, MIX, args.in[10], lds); group_wait(ctl, xg, xg_epoch, CW_XG); }
    if (IN(5)) REPS(6) { gla::passB(args, lds); }
    if (IN(6)) { pg8::Gemm g{MIX, (const bf16*)(ws + W_OUT), T_ROWS, DM, DM}; RepOrder S; S.init2(T_ROWS, DM, G, (int)blockIdx.x, NREP(7));
        xg_epoch += (unsigned)(G >> 3); group_arrive(ctl, xg, xg_rel, CW_XG); PreSeam p6 = pre; p6.kind = 5; p6.xtarget = xg_epoch;
        pg8::EpiResid E{XB, SSQ2, 1.0f}; pg8::gemm_phase<pg8::EpiResid, RepOrder, false, true, PreSeam>(lds, g, S, E, p6); }
    if (IN(7)) { pg8::Gemm g{XB, (const bf16*)(ws + W_2GU), T_ROWS, NGU, DM}; RepOrder S; S.init2(T_ROWS, NGU, G, (int)blockIdx.x, 1);
        team_epoch += 4u; group_arrive(ctl, team_key, team_rel, CW_TEAM); PreSeam p7 = pre; p7.kind = 4; p7.target = team_epoch; p7.ssqA = SSQ2; p7.nA = 16;
        pg8::EpiSwiGLU E{ACT, FF, rt, k8, -1, -1};
#if (PROBE_MASK >> 26) & 1
        { SliceOrder S1; S1.init(T_ROWS, NGU, G, (int)blockIdx.x); S1.i0 = 0; S1.i1 = 6; pg8::gemm_phase<pg8::EpiSwiGLU, SliceOrder, true, true, PreSeam>(lds, g, S1, E, p7);
#if (PROBE_MASK >> 28) & 1
          PreSeam p7b = pre; p7b.kind = 0;
#elif (PROBE_MASK >> 29) & 1
          team_epoch += 4u; group_arrive(ctl, team_key, team_rel, CW_TEAM); PreSeam p7b = pre; p7b.kind = 4; p7b.target = team_epoch;
#else
          team_epoch += 4u; group_arrive(ctl, team_key, team_rel, CW_TEAM); PreSeam p7b = pre; p7b.kind = 4; p7b.target = team_epoch; p7b.ssqA = SSQ2; p7b.nA = 16;
#endif
          SliceOrder S2; S2.init(T_ROWS, NGU, G, (int)blockIdx.x); S2.i0 = 6; S2.i1 = 11; pg8::gemm_phase<pg8::EpiSwiGLU, SliceOrder, true, true, PreSeam>(lds, g, S2, E, p7b); }
#else
        pg8::gemm_phase<pg8::EpiSwiGLU, RepOrder, true, true, PreSeam>(lds, g, S, E, p7);
#endif
        }
    if (IN(8) && !(xg & 1) && EMB_MODE == 2) { group_arrive(ctl, team_key, team_rel, CW_TEAM);
        pg8::Gemm g{PB, (const bf16*)(ws + W_PP), T_ROWS, DM, PLE}; RepOrder S; S.init2(T_ROWS, DM, G, (int)blockIdx.x, NREP(11));
        pg8::EpiEmb E{EMB, SSQ4}; pg8::gemm_phase<pg8::EpiEmb, RepOrder, true, true>(lds, g, S, E); }
    if (IN(8)) { pg8::Gemm g{ACT, (const bf16*)(ws + W_2D), T_ROWS, DM, FF}; RepOrder S; S.init2(T_ROWS, DM, G, (int)blockIdx.x, NREP(8));
        team_epoch += 4u; if (!(!(xg & 1) && EMB_MODE == 2)) group_arrive(ctl, team_key, team_rel, CW_TEAM); PreSeam p8 = pre; p8.kind = 4; p8.target = team_epoch;
        pg8::EpiResid E{XB, SSQ3, 0.5f}; pg8::gemm_phase<pg8::EpiResid, RepOrder, false, true, PreSeam>(lds, g, S, E, p8); }
    if (IN(9) && !(xg & 1) && EMB_MODE == 3) { team_epoch += 4u; group_arrive(ctl, team_key, team_rel, CW_TEAM); }
    if (IN(9) && !(xg & 1) && EMB_MODE != 2) { pg8::Gemm g{PB, (const bf16*)(ws + W_PP), T_ROWS, DM, PLE}; RepOrder S; S.init2(T_ROWS, DM, G, (int)blockIdx.x, NREP(11));
        pg8::EpiEmb E{EMB, SSQ4}; pg8::gemm_phase<pg8::EpiEmb, RepOrder, true, true>(lds, g, S, E); }
    if (IN(9)) { pg8::Gemm g{XB, (const bf16*)(ws + W_PG), T_ROWS, DM, DM}; RepOrder S; S.init2(T_ROWS, DM, G, (int)blockIdx.x, NREP(9));
        team_epoch += 4u; group_arrive(ctl, team_key, team_rel, CW_TEAM); PreSeam p9 = pre; p9.kind = 4; p9.target = team_epoch; p9.ssqA = SSQ3; p9.nA = 16; p9.ssqB = SSQ4; p9.nB = 16;
        pg8::EpiPle E{args.out, XB, EMB, rt, rt + 1024, k8, -1, -1, args.in[22]}; pg8::gemm_phase<pg8::EpiPle, RepOrder, false, true, PreSeam>(lds, g, S, E, p9); }
#undef IN
#undef SEAM
}

#ifndef MK_N_LAUNCHES
#define MK_N_LAUNCHES 1
#endif
extern "C" void kernel_launch(void* const* d_in, const int* in_sizes, int n_in, void* d_out, int out_size, void* d_ws, size_t ws_size, hipStream_t stream) {
    static int grid = 0;
    if (grid == 0) {
        if (n_in != 23 || out_size != T_ROWS * DM || ws_size < WS_END) { fprintf(stderr, "kernel_launch: unexpected shapes: n_in %d out %d ws %zu (need %zu)\n", n_in, out_size, ws_size, (size_t)WS_END); grid = -1; return; }
        int dev = 0, cus = 0, per_cu = 0;
        if (hipGetDevice(&dev) != hipSuccess || hipDeviceGetAttribute(&cus, hipDeviceAttributeMultiprocessorCount, dev) != hipSuccess) { grid = -1; return; }
        if (hipFuncSetAttribute((const void*)hymba_fwd, hipFuncAttributeMaxDynamicSharedMemorySize, LDS_BYTES) != hipSuccess) { fprintf(stderr, "kernel_launch: hipFuncSetAttribute failed\n"); grid = -1; return; }
        if (hipOccupancyMaxActiveBlocksPerMultiprocessor(&per_cu, (const void*)hymba_fwd, NWAVES * 64, LDS_BYTES) != hipSuccess || per_cu < 1) { fprintf(stderr, "kernel_launch: occupancy query says %d\n", per_cu); per_cu = 1; }
        (void)hipGetLastError();
        if (cus != 256) { fprintf(stderr, "kernel_launch: built for a 256-CU device (teams of 4 and groups of 32 workgroups come from the 256-workgroup unit order); this one reports %d CUs; nothing launched\n", cus); grid = -1; return; }
        grid = cus;
        fprintf(stderr, "kernel_launch: cus %d per_cu %d grid %d ws %zu\n", cus, per_cu, grid, ws_size);
    }
    if (grid < 0) return;
    if (hipMemsetAsync((char*)d_ws + WS_CTL, 0, CTL_MEMSET_BYTES, stream) != hipSuccess) { fprintf(stderr, "kernel_launch: hipMemsetAsync failed\n"); return; }
    Args a{};
    for (int i = 0; i < 23; ++i) a.in[i] = (const float*)d_in[i];
    a.out = (float*)d_out; a.ws = (unsigned char*)d_ws;
    for (int li = 0; li < MK_N_LAUNCHES; ++li) {
        a.ph_lo = (MK_N_LAUNCHES == 1) ? 0 : li; a.ph_hi = (MK_N_LAUNCHES == 1) ? N_PHASES : li + 1;
        void* kargs[] = {&a};
        hipError_t e = hipLaunchCooperativeKernel((void*)hymba_fwd, dim3(grid), dim3(NWAVES * 64), kargs, LDS_BYTES, stream);
        if (e != hipSuccess) { fprintf(stderr, "kernel_launch: launch %d failed: %s\n", li, hipGetErrorString(e)); break; }
    }
}
```

```cpp
#include <hip/hip_runtime.h>
#include <cstdio>
#include <cstdint>
namespace pg8 {
#define PG8_LAS __attribute__((address_space(3)))
typedef unsigned short bf16_t;
typedef short bf16x8 __attribute__((ext_vector_type(8)));
typedef float f32x4 __attribute__((ext_vector_type(4)));
typedef unsigned u32x4 __attribute__((ext_vector_type(4)));
constexpr int BM = 256, BK = 64, HALF = 128, HTB = HALF * BK * 2  , STAGE_BYTES = 8 * HTB, NXCD = 8, WGM = 8;

__host__ __device__ __forceinline__ int lds_byte(int r, int c) { const int st = (r >> 4) * 2 + (c >> 5), rr = r & 15, cc = c & 31, ob = rr * 64 + cc * 2; return st * 1024 + (ob ^ (((ob >> 9) & 1) << 5)); }
__host__ __device__ __forceinline__ void stage_rc(int b, int& R, int& C) { const int st = b / 1024, sb = b % 1024, swz = sb ^ (((sb >> 9) & 1) << 5); R = (st >> 1) * 16 + swz / 64; C = (st & 1) * 32 + (swz % 64) / 2; }
__host__ __device__ __forceinline__ int perm32(int rho) { const int n = rho >> 4, i = rho & 15; return 8 * (i >> 2) + 4 * n + (i & 3); }

struct Unit { int pm, pn, aux; };
struct Gemm { const bf16_t* A; const bf16_t* Bt; int M, N, K; };

struct StaticOrder {
    int nM, nN, nwg, G, c;
    __host__ __device__ __forceinline__ void init(int M, int N, int G_, int c_) { nM = M / BM; nN = N / BM; nwg = nM * nN; G = G_; c = c_; }
    __host__ __device__ __forceinline__ bool next(int i, Unit& u) const {
        const long L = (long)i * G + c; if (L >= nwg) return false;
        int wgid = (int)L; { const int q = nwg / NXCD, r = nwg % NXCD, xcd = wgid % NXCD, off = wgid / NXCD; wgid = (xcd < r ? xcd * (q + 1) : r * (q + 1) + (xcd - r) * q) + off; }
        const int nig = WGM * nN, gid = wgid / nig, fm = gid * WGM, gsz = (nM - fm) < WGM ? (nM - fm) : WGM;
        u.pm = fm + ((wgid % nig) % gsz); u.pn = (wgid % nig) / gsz; return true;
    }
    __device__ __forceinline__ void a_ready(const Unit&) const {}
    __device__ __forceinline__ void done(const Unit&) const {}
};
__device__ __forceinline__ unsigned cvt_pk_bf16(float lo, float hi) { unsigned r; asm volatile("v_cvt_pk_bf16_f32 %0, %1, %2" : "=v"(r) : "v"(lo), "v"(hi)); return r; }
typedef float f32x2 __attribute__((ext_vector_type(2)));
constexpr float RMS_EPS = 1e-6f;
__device__ __forceinline__ void st16_wt(void* p, const u32x4 v) { asm volatile("global_store_dwordx4 %0, %1, off sc1\n\ts_nop 1" :: "v"(p), "v"(v) : "memory"); }
constexpr int Z_PANEL = 256 * 2816, Z_PITCH = 2560;
__device__ __forceinline__ size_t zoff(int row) { return (size_t)(row >> 8) * Z_PANEL + (size_t)(row & 255) * Z_PITCH; }
constexpr int SSQ_LD = 32768;
__device__ __forceinline__ float rstd_row(const float* ssq, int row, int nslots, float inv_n) {
    float s;
    if (nslots == 1) s = ssq[row];
    else { float v[16];
#pragma unroll
        for (int k = 0; k < 16; ++k) v[k] = ssq[(size_t)k * SSQ_LD + row];
        s = (((v[0] + v[1]) + (v[2] + v[3])) + ((v[4] + v[5]) + (v[6] + v[7]))) + (((v[8] + v[9]) + (v[10] + v[11])) + ((v[12] + v[13]) + (v[14] + v[15]))); }
    return __builtin_amdgcn_rsqf(s * inv_n + RMS_EPS); }
__device__ __forceinline__ float silu_f(float x) { return x * __builtin_amdgcn_rcpf(1.0f + __builtin_amdgcn_exp2f(-1.4426950408889634f * x)); }
__device__ __forceinline__ float sigmoid_f(float x) { return __builtin_amdgcn_rcpf(1.0f + __builtin_amdgcn_exp2f(-1.4426950408889634f * x)); }
__device__ __forceinline__ u32x4 pack8(const f32x4 a, const f32x4 b) { u32x4 w; w.x = cvt_pk_bf16(a[0], a[1]); w.y = cvt_pk_bf16(a[2], a[3]); w.z = cvt_pk_bf16(b[0], b[1]); w.w = cvt_pk_bf16(b[2], b[3]); return w; }
__device__ __forceinline__ float sq4(const f32x4 a) { return (a[0] * a[0] + a[1] * a[1]) + (a[2] * a[2] + a[3] * a[3]); }

typedef float f32x2 __attribute__((ext_vector_type(2)));
__device__ __forceinline__ f32x4 exp2_4(const f32x4 t) { return (f32x4){__builtin_amdgcn_exp2f(t[0]), __builtin_amdgcn_exp2f(t[1]), __builtin_amdgcn_exp2f(t[2]), __builtin_amdgcn_exp2f(t[3])}; }
__device__ __forceinline__ f32x4 rcp_4(const f32x4 t) { return (f32x4){__builtin_amdgcn_rcpf(t[0]), __builtin_amdgcn_rcpf(t[1]), __builtin_amdgcn_rcpf(t[2]), __builtin_amdgcn_rcpf(t[3])}; }
struct EpiSwiGLU {
    static constexpr bool PERM = true, AFTER_DRAIN = false;
    bf16_t* O; int ldo; const PG8_LAS float* rt; int pm1, pm2, pm3;
    __device__ __forceinline__ void operator()(const f32x4 (&acc)[2][2][4][2], const Unit& u, int wr, int wc, int fr, int fq) const {
        const int row0 = u.pm * BM + wr * 64 + fr, col0 = u.pn * HALF + wc * 32 + 8 * fq; const PG8_LAS float* rp = rt + 256 * ((u.pm == pm1) + 2 * (u.pm == pm2) + 3 * (u.pm == pm3)) + wr * 64 + fr;
#pragma unroll
        for (int ai = 0; ai < 2; ++ai)
#pragma unroll
            for (int m = 0; m < 4; ++m) { const int row = row0 + ai * HALF + m * 16; const float r = rp[ai * HALF + m * 16], nr = r * -1.4426950408889634f, r2 = r * r;
                f32x4 o[2];
#pragma unroll
                for (int n = 0; n < 2; ++n) { const f32x4 g = acc[ai][0][m][n], up = acc[ai][1][m][n]; const f32x4 q = rcp_4(exp2_4(g * nr) + 1.0f); o[n] = ((g * up) * r2) * q; }
                st16_wt(O + (size_t)row * ldo + col0, pack8(o[0], o[1])); }
    }
};
__device__ __forceinline__ void unpack8(const u32x4 w, f32x4& a, f32x4& b) {
    a[0] = __uint_as_float(w.x << 16); a[1] = __uint_as_float(w.x & 0xffff0000u); a[2] = __uint_as_float(w.y << 16); a[3] = __uint_as_float(w.y & 0xffff0000u);
    b[0] = __uint_as_float(w.z << 16); b[1] = __uint_as_float(w.z & 0xffff0000u); b[2] = __uint_as_float(w.w << 16); b[3] = __uint_as_float(w.w & 0xffff0000u);
}
struct EpiResid {
    static constexpr bool PERM = true, AFTER_DRAIN = false;
    bf16_t* hb; float* ssq; float scale;
    __device__ __forceinline__ void operator()(const f32x4 (&acc)[2][2][4][2], const Unit& u, int wr, int wc, int fr, int fq) const {
        const int row0 = u.pm * BM + wr * 64 + fr, col0 = u.pn * BM + wc * 32 + 8 * fq;
        const float sc = u.aux ? 0.f : scale;
        u32x4 bw[2][4][2];
#pragma unroll
        for (int ai = 0; ai < 2; ++ai)
#pragma unroll
            for (int m = 0; m < 4; ++m)
#pragma unroll
                for (int bj = 0; bj < 2; ++bj) bw[ai][m][bj] = *(const u32x4*)(hb + (size_t)(row0 + ai * HALF + m * 16) * 1024 + col0 + bj * HALF);
#pragma unroll
        for (int ai = 0; ai < 2; ++ai)
#pragma unroll
            for (int m = 0; m < 4; ++m) { const int row = row0 + ai * HALF + m * 16; const size_t off = (size_t)row * 1024 + col0; float s = 0.f;
#pragma unroll
                for (int bj = 0; bj < 2; ++bj) { f32x4 b0, b1; unpack8(bw[ai][m][bj], b0, b1);
                    const f32x4 h0 = b0 + acc[ai][bj][m][0] * sc, h1 = b1 + acc[ai][bj][m][1] * sc;
                    *(u32x4*)(hb + off + bj * HALF) = pack8(h0, h1); s += sq4(h0) + sq4(h1); }
                s += __shfl_xor(s, 16); s += __shfl_xor(s, 32);
                if (fq == 0) ssq[(size_t)(u.pn * 4 + wc) * SSQ_LD + row] = s; }
    }
};
struct EpiZ {
    static constexpr bool PERM = true, AFTER_DRAIN = false;
    bf16_t* Z; const PG8_LAS float* rt; int pm1, pm2, pm3; const float* cosT; const float* sinT; const float* qn; const float* kn;
    __device__ __forceinline__ void operator()(const f32x4 (&acc)[2][2][4][2], const Unit& u, int wr, int wc, int fr, int fq) const {
        const int row0 = u.pm * BM + wr * 64 + fr, col0 = u.pn * BM + wc * 64 + 8 * fq; const PG8_LAS float* rp = rt + 256 * ((u.pm == pm1) + 2 * (u.pm == pm2) + 3 * (u.pm == pm3)) + wr * 64 + fr;
        const bool rope = (u.pn < 2) || (u.pn == 2 && wc < 2);
        const float osc = (u.pn < 2) ? 0.125f * 1.4426950408889634f : (u.pn == 3 ? 0.125f : 1.0f);
        if (rope) {
            const float* gn = (u.pn < 2) ? qn : kn;
            const f32x4 gl0 = *(const f32x4*)(gn + 8 * fq) * osc, gl1 = *(const f32x4*)(gn + 8 * fq + 4) * osc, gh0 = *(const f32x4*)(gn + 32 + 8 * fq) * osc, gh1 = *(const f32x4*)(gn + 32 + 8 * fq + 4) * osc;
#pragma unroll
            for (int aim = 0; aim < 4; ++aim) { const int ai = aim >> 1, mb = (aim & 1) * 2;
                f32x4 c0[4], c1[4], s0[4], s1[4];
#pragma unroll
                for (int m = mb; m < mb + 2; ++m) { const int pos = (row0 + ai * HALF + m * 16) & 4095;
                    c0[m] = *(const f32x4*)(cosT + pos * 32 + 8 * fq); c1[m] = *(const f32x4*)(cosT + pos * 32 + 8 * fq + 4); s0[m] = *(const f32x4*)(sinT + pos * 32 + 8 * fq); s1[m] = *(const f32x4*)(sinT + pos * 32 + 8 * fq + 4); }
#pragma unroll
                for (int m = mb; m < mb + 2; ++m) { const int row = row0 + ai * HALF + m * 16; const float r1 = rp[ai * HALF + m * 16];
                    f32x4 lo0 = acc[ai][0][m][0] * r1, lo1 = acc[ai][0][m][1] * r1, hi0 = acc[ai][1][m][0] * r1, hi1 = acc[ai][1][m][1] * r1;
                    float ss = (sq4(lo0) + sq4(lo1)) + (sq4(hi0) + sq4(hi1)); ss += __shfl_xor(ss, 16); ss += __shfl_xor(ss, 32);
                    const float rn = __builtin_amdgcn_rsqf(ss * (1.0f / 64.0f) + RMS_EPS);
                    lo0 = lo0 * rn * gl0; lo1 = lo1 * rn * gl1; hi0 = hi0 * rn * gh0; hi1 = hi1 * rn * gh1;
                    const f32x4 nl0 = lo0 * c0[m] - hi0 * s0[m], nl1 = lo1 * c1[m] - hi1 * s1[m], nh0 = hi0 * c0[m] + lo0 * s0[m], nh1 = hi1 * c1[m] + lo1 * s1[m];
                    bf16_t* zp = Z + zoff(row) + col0;
                    *(u32x4*)(zp) = pack8(nl0, nl1); *(u32x4*)(zp + 32) = pack8(nh0, nh1); }
                asm volatile("" ::: "memory"); }
        } else {
#pragma unroll
            for (int ai = 0; ai < 2; ++ai)
#pragma unroll
                for (int m = 0; m < 4; ++m) { const int row = row0 + ai * HALF + m * 16; const float r1 = rp[ai * HALF + m * 16] * osc;
                    bf16_t* zp = Z + zoff(row) + col0;
                    *(u32x4*)(zp) = pack8(acc[ai][0][m][0] * r1, acc[ai][0][m][1] * r1); *(u32x4*)(zp + 32) = pack8(acc[ai][1][m][0] * r1, acc[ai][1][m][1] * r1); }
        }
    }
};
struct EpiEmb {
    static constexpr bool PERM = true, AFTER_DRAIN = false;
    bf16_t* E; float* ssq;
    __device__ __forceinline__ void operator()(const f32x4 (&acc)[2][2][4][2], const Unit& u, int wr, int wc, int fr, int fq) const {
        const int row0 = u.pm * BM + wr * 64 + fr, col0 = u.pn * BM + wc * 32 + 8 * fq;
#pragma unroll
        for (int ai = 0; ai < 2; ++ai)
#pragma unroll
            for (int m = 0; m < 4; ++m) { const int row = row0 + ai * HALF + m * 16; const size_t off = (size_t)row * 1024 + col0; float s = 0.f;
#pragma unroll
                for (int bj = 0; bj < 2; ++bj) { *(u32x4*)(E + off + bj * HALF) = pack8(acc[ai][bj][m][0], acc[ai][bj][m][1]); s += sq4(acc[ai][bj][m][0]) + sq4(acc[ai][bj][m][1]); }
                s += __shfl_xor(s, 16); s += __shfl_xor(s, 32);
                if (fq == 0) ssq[(size_t)(u.pn * 4 + wc) * SSQ_LD + row] = s; }
    }
};
struct EpiPle {
    static constexpr bool PERM = true, AFTER_DRAIN = false;
    float* out; const bf16_t* hb; const bf16_t* E; const PG8_LAS float* rth; const PG8_LAS float* rte; int pm1, pm2, pm3; const float* gain;
    __device__ __forceinline__ void operator()(const f32x4 (&acc)[2][2][4][2], const Unit& u, int wr, int wc, int fr, int fq) const {
        const int row0 = u.pm * BM + wr * 64 + fr, col0 = u.pn * BM + wc * 32 + 8 * fq, ro = 256 * ((u.pm == pm1) + 2 * (u.pm == pm2) + 3 * (u.pm == pm3)) + wr * 64 + fr;
        f32x4 gv[2][2];
#pragma unroll
        for (int bj = 0; bj < 2; ++bj) { gv[bj][0] = *(const f32x4*)(gain + col0 + bj * HALF); gv[bj][1] = *(const f32x4*)(gain + col0 + bj * HALF + 4); }
#pragma unroll
        for (int aim = 0; aim < 4; ++aim) { const int ai = aim >> 1, mb = (aim & 1) * 2;
            u32x4 ew[4][2], hw[4][2];
#pragma unroll
            for (int m = mb; m < mb + 2; ++m)
#pragma unroll
                for (int bj = 0; bj < 2; ++bj) { const size_t off = (size_t)(row0 + ai * HALF + m * 16) * 1024 + col0 + bj * HALF; ew[m][bj] = *(const u32x4*)(E + off); hw[m][bj] = *(const u32x4*)(hb + off); }
#pragma unroll
            for (int m = mb; m < mb + 2; ++m) { const int row = row0 + ai * HALF + m * 16; const size_t off = (size_t)row * 1024 + col0;
                const float rh = rth[ro + ai * HALF + m * 16] * -1.4426950408889634f, re = rte[ro + ai * HALF + m * 16];
#pragma unroll
                for (int bj = 0; bj < 2; ++bj) { f32x4 e0, e1, b0, b1; unpack8(ew[m][bj], e0, e1); unpack8(hw[m][bj], b0, b1);
                    const f32x4 q0 = rcp_4(exp2_4(acc[ai][bj][m][0] * rh) + 1.0f), q1 = rcp_4(exp2_4(acc[ai][bj][m][1] * rh) + 1.0f);
                    const f32x4 o0 = b0 + q0 * ((e0 * re) * gv[bj][0]), o1 = b1 + q1 * ((e1 * re) * gv[bj][1]);
                    __builtin_nontemporal_store(o0, (f32x4*)(out + off + bj * HALF)); __builtin_nontemporal_store(o1, (f32x4*)(out + off + bj * HALF + 4)); } }
            asm volatile("" ::: "memory"); }
    }
};
struct EpiNone {
    static constexpr bool PERM = true, AFTER_DRAIN = false;
    __device__ __forceinline__ void operator()(const f32x4 (&acc)[2][2][4][2], const Unit& u, int wr, int wc, int fr, int fq) const {
#pragma unroll
        for (int ai = 0; ai < 2; ++ai)
#pragma unroll
            for (int bj = 0; bj < 2; ++bj)
#pragma unroll
                for (int m = 0; m < 4; ++m)
#pragma unroll
                    for (int n = 0; n < 2; ++n) asm volatile("" :: "v"(acc[ai][bj][m][n]));
    }
};
struct PreNone { __device__ __forceinline__ void operator()() const {} __device__ __forceinline__ void post() const {} };
template <class Epi, class Sched, bool ALIGN_EPI = false, bool SP2 = false, class Pre = PreNone>
__device__ __forceinline__ void gemm_phase(PG8_LAS unsigned char* lds, const Gemm g, const Sched& S, const Epi& E, const Pre& pre = Pre()) {
    const int tid = threadIdx.x, wid = __builtin_amdgcn_readfirstlane(tid >> 6), lane = tid & 63, wr = wid >> 2, wc = wid & 3, fr = lane & 15, fq = lane >> 4;
    const int K = g.K, nt = K / BK;
    unsigned voffA[2], voffB[2];
#pragma unroll
    for (int i = 0; i < 2; ++i) { int R, C; stage_rc(tid * 16 + i * 8192, R, C); const int Rb = Epi::PERM ? ((R & ~31) + perm32(R & 31)) : R;
        voffA[i] = (unsigned)(R * K + C) * 2u; voffB[i] = (unsigned)(Rb * K + C) * 2u; }
    const size_t kstep = (size_t)(BK * 2);
    const size_t hstep = (size_t)HALF * K * 2;
    const size_t tstep = 2 * hstep;
    const unsigned ldsw = (unsigned)wid * 1024u;
    const int aoff = lds_byte(wr * 64 + fr, fq * 8), boff = lds_byte(wc * 32 + fr, fq * 8);
#define PG8_SA(b, h) (((b) * 2 + (h)) * HTB)
#define PG8_SB(b, h) ((4 + (b) * 2 + (h)) * HTB)
#define PG8_STAGE(bufoff, gbase, voff) do { _Pragma("unroll") for (int _i = 0; _i < 2; ++_i) \
        __builtin_amdgcn_global_load_lds((const unsigned*)((const char*)(gbase) + (voff)[_i]), (PG8_LAS unsigned*)(lds + (bufoff) + ldsw + _i * 8192), 16, 0, 0); } while (0)
#define PG8_LDA(dst, b, h) do { _Pragma("unroll") for (int m = 0; m < 4; ++m) _Pragma("unroll") for (int k = 0; k < 2; ++k) dst[m][k] = *(const PG8_LAS bf16x8*)(lds + PG8_SA(b, h) + aoff + m * 2048 + k * 1024); } while (0)
#define PG8_LDB(dst, b, h) do { _Pragma("unroll") for (int n = 0; n < 2; ++n) _Pragma("unroll") for (int k = 0; k < 2; ++k) dst[n][k] = *(const PG8_LAS bf16x8*)(lds + PG8_SB(b, h) + boff + n * 2048 + k * 1024); } while (0)
#define PG8_MMA(ai, bj, At, Bt) do { __builtin_amdgcn_s_setprio(1); _Pragma("unroll") for (int m = 0; m < 4; ++m) _Pragma("unroll") for (int n = 0; n < 2; ++n) _Pragma("unroll") for (int k = 0; k < 2; ++k) \
        acc[ai][bj][m][n] = __builtin_amdgcn_mfma_f32_16x16x32_bf16(Bt[n][k], At[m][k], acc[ai][bj][m][n], 0, 0, 0); __builtin_amdgcn_s_setprio(0); } while (0)
#define PG8_WAIT_V(n) asm volatile("s_waitcnt vmcnt(" #n ")" ::: "memory")
#define PG8_WAIT_L(n) asm volatile("s_waitcnt lgkmcnt(" #n ")" ::: "memory")
#define PG8_BAR __builtin_amdgcn_s_barrier()
#define PG8_SCHED __builtin_amdgcn_sched_barrier(0)
    Unit cur, nxt; int ui = 0;
    if (!S.next(0, cur)) return;
    f32x4 acc[2][2][4][2];
#pragma unroll
    for (int a = 0; a < 2; ++a)
#pragma unroll
        for (int b = 0; b < 2; ++b)
#pragma unroll
            for (int m = 0; m < 4; ++m)
#pragma unroll
                for (int n = 0; n < 2; ++n) acc[a][b][m][n] = (f32x4){0.f, 0.f, 0.f, 0.f};
    bf16x8 At[4][2], B0[2][2], B1[2][2];
    const char* cA = (const char*)g.A + (size_t)cur.pm * tstep; const char* cB = (const char*)g.Bt + (size_t)cur.pn * tstep;
    S.a_ready(cur);
    if constexpr (SP2) {
        PG8_STAGE(PG8_SB(0, 0), cB, voffB); PG8_STAGE(PG8_SB(0, 1), cB + hstep, voffB); pre(); PG8_STAGE(PG8_SA(0, 0), cA, voffA); PG8_STAGE(PG8_SA(0, 1), cA + hstep, voffA); pre.post();
        if (wr == 1) PG8_BAR;
        PG8_WAIT_V(2); PG8_BAR;
        PG8_STAGE(PG8_SB(1, 0), cB + kstep, voffB); PG8_STAGE(PG8_SA(1, 0), cA + kstep, voffA); PG8_STAGE(PG8_SB(1, 1), cB + hstep + kstep, voffB);
        PG8_WAIT_V(6); PG8_BAR;
    } else {
        pre(); PG8_STAGE(PG8_SB(0, 0), cB, voffB); PG8_STAGE(PG8_SA(0, 0), cA, voffA); PG8_STAGE(PG8_SB(0, 1), cB + hstep, voffB); PG8_STAGE(PG8_SA(0, 1), cA + hstep, voffA);
        if (wr == 1) PG8_BAR;
        PG8_WAIT_V(4); PG8_BAR;
        PG8_STAGE(PG8_SB(1, 0), cB + kstep, voffB); PG8_STAGE(PG8_SA(1, 0), cA + kstep, voffA); PG8_STAGE(PG8_SB(1, 1), cB + hstep + kstep, voffB);
        PG8_WAIT_V(6); PG8_BAR;
    }
    for (;;) {
        const bool has_next = S.next(ui + 1, nxt);
        const char* nA = has_next ? (const char*)g.A + (size_t)nxt.pm * tstep : cA; const char* nB = has_next ? (const char*)g.Bt + (size_t)nxt.pn * tstep : cB;
        for (int t = 0; t < nt; t += 2) {
            const bool last = (t == nt - 2);
            const char* a1 = cA + (size_t)(t + 1) * kstep;
            const char* a2 = last ? nA : cA + (size_t)(t + 2) * kstep; const char* b2 = last ? nB : cB + (size_t)(t + 2) * kstep;
            const char* a3 = a2 + kstep; const char* b3 = b2 + kstep;
            if (last && has_next) S.a_ready(nxt);
            if constexpr (SP2) {
            PG8_LDB(B0, 0, 0); PG8_LDB(B1, 0, 1); PG8_SCHED; PG8_LDA(At, 0, 0); PG8_STAGE(PG8_SA(1, 1), a1 + hstep, voffA);
            PG8_WAIT_V(8); PG8_WAIT_L(0); PG8_BAR; PG8_MMA(0, 0, At, B0); PG8_MMA(0, 1, At, B1); PG8_BAR; PG8_SCHED;
            PG8_LDA(At, 0, 1); PG8_STAGE(PG8_SB(0, 0), b2, voffB); PG8_STAGE(PG8_SB(0, 1), b2 + hstep, voffB); PG8_STAGE(PG8_SA(0, 0), a2, voffA);
            PG8_WAIT_V(8); PG8_WAIT_L(0); PG8_BAR; PG8_MMA(1, 0, At, B0); PG8_MMA(1, 1, At, B1); PG8_BAR; PG8_SCHED;
            PG8_LDB(B0, 1, 0); PG8_LDB(B1, 1, 1); PG8_SCHED; PG8_LDA(At, 1, 0); PG8_STAGE(PG8_SA(0, 1), a2 + hstep, voffA);
            PG8_WAIT_V(8); PG8_WAIT_L(0); PG8_BAR; PG8_MMA(0, 0, At, B0); PG8_MMA(0, 1, At, B1); PG8_BAR; PG8_SCHED;
            PG8_LDA(At, 1, 1); PG8_STAGE(PG8_SB(1, 0), b3, voffB); PG8_STAGE(PG8_SB(1, 1), b3 + hstep, voffB); PG8_STAGE(PG8_SA(1, 0), a3, voffA);
            PG8_WAIT_V(8); PG8_WAIT_L(0); PG8_BAR; PG8_MMA(1, 0, At, B0); PG8_MMA(1, 1, At, B1); PG8_BAR; PG8_SCHED;
            } else {
            PG8_LDB(B0, 0, 0); PG8_SCHED; PG8_LDA(At, 0, 0); PG8_STAGE(PG8_SA(1, 1), a1 + hstep, voffA);
            PG8_WAIT_L(8); PG8_BAR; PG8_WAIT_L(0); PG8_MMA(0, 0, At, B0); PG8_BAR; PG8_SCHED;
            PG8_LDB(B1, 0, 1); PG8_STAGE(PG8_SB(0, 0), b2, voffB);
            PG8_BAR; PG8_WAIT_L(0); PG8_MMA(0, 1, At, B1); PG8_BAR;
            PG8_LDA(At, 0, 1); PG8_STAGE(PG8_SA(0, 0), a2, voffA);
            PG8_BAR; PG8_WAIT_L(0); PG8_MMA(1, 0, At, B0); PG8_BAR; PG8_SCHED;
            PG8_STAGE(PG8_SB(0, 1), b2 + hstep, voffB);
            PG8_WAIT_V(6); PG8_BAR; PG8_MMA(1, 1, At, B1); PG8_BAR;
            PG8_LDB(B0, 1, 0); PG8_SCHED; PG8_LDA(At, 1, 0); PG8_STAGE(PG8_SA(0, 1), a2 + hstep, voffA);
            PG8_WAIT_L(8); PG8_BAR; PG8_WAIT_L(0); PG8_MMA(0, 0, At, B0); PG8_BAR; PG8_SCHED;
            PG8_LDB(B1, 1, 1); PG8_STAGE(PG8_SB(1, 0), b3, voffB);
            PG8_BAR; PG8_WAIT_L(0); PG8_MMA(0, 1, At, B1); PG8_BAR;
            PG8_LDA(At, 1, 1); PG8_STAGE(PG8_SA(1, 0), a3, voffA);
            PG8_BAR; PG8_WAIT_L(0); PG8_MMA(1, 0, At, B0); PG8_BAR; PG8_SCHED;
            PG8_STAGE(PG8_SB(1, 1), b3 + hstep, voffB);
            PG8_WAIT_V(6); PG8_BAR; PG8_MMA(1, 1, At, B1); PG8_BAR;
            }
        }
        if constexpr (ALIGN_EPI) { if (wr == 0) PG8_BAR; }
        if constexpr (!Epi::AFTER_DRAIN) { E(acc, cur, wr, wc, fr, fq); S.done(cur); }
        if (!has_next) break;
#pragma unroll
        for (int a = 0; a < 2; ++a)
#pragma unroll
            for (int b = 0; b < 2; ++b)
#pragma unroll
                for (int m = 0; m < 4; ++m)
#pragma unroll
                    for (int n = 0; n < 2; ++n) acc[a][b][m][n] = (f32x4){0.f, 0.f, 0.f, 0.f};
        cur = nxt; cA = nA; cB = nB; ++ui;
        if constexpr (ALIGN_EPI) { if (wr == 1) PG8_BAR; }
    }
    PG8_WAIT_V(0);
    if constexpr (!ALIGN_EPI) { if (wr == 0) PG8_BAR; }
    PG8_BAR;
    if constexpr (Epi::AFTER_DRAIN) { E.fused(acc, cur, wr, wc, fr, fq, lds, wid, lane); S.done(cur); }
#undef PG8_SA
#undef PG8_SB
#undef PG8_STAGE
#undef PG8_LDA
#undef PG8_LDB
#undef PG8_MMA
#undef PG8_WAIT_V
#undef PG8_WAIT_L
#undef PG8_BAR
#undef PG8_SCHED
}
}
#ifndef PROBE_MASK
#define PROBE_MASK 0
#endif
#ifndef NTA
#define NTA 0
#endif
#include <hip/hip_cooperative_groups.h>
namespace cg = cooperative_groups;
constexpr int NWAVES = 8;
constexpr int T_ROWS = 32768, SEQ = 4096, DM = 1024, FF = 2816, NGU = 2 * FF, NIN = 2560, PLE = 256, ZP = NIN;
constexpr int ZC_AQ = 0, ZC_AK = 512, ZC_AV = 640, ZC_GQ = 768, ZC_GK = 1024, ZC_GV = 1280, ZC_GOG = 1792, ZC_GLR = 2304;
constexpr size_t MiB = 1u << 20;
constexpr size_t WS_CTL = 0, CTL_ZERO_BYTES = 1 * MiB;
constexpr size_t WS_TAB = 1 * MiB;
constexpr size_t WS_SSQ = 2 * MiB, SSQ_BYTES = 2 * MiB;
constexpr size_t WS_DEC = 12 * MiB;
constexpr size_t WS_AG = 12 * MiB + 768 * 1024;
constexpr size_t WS_W = 14 * MiB;
constexpr size_t W_1GU = WS_W, W_1D = W_1GU + (size_t)NGU * DM * 2, W_IN = W_1D + (size_t)DM * FF * 2, W_OUT = W_IN + (size_t)NIN * DM * 2, W_2GU = W_OUT + (size_t)DM * DM * 2,
                 W_2D = W_2GU + (size_t)NGU * DM * 2, W_PG = W_2D + (size_t)DM * FF * 2, W_PP = W_PG + (size_t)DM * DM * 2, W_END = W_PP + (size_t)DM * PLE * 2;
constexpr size_t WS_PB = 58 * MiB, WS_XB = 74 * MiB, WS_ACT = 138 * MiB, WS_MIX = 314 * MiB, WS_EMB = 378 * MiB, WS_GS = 442 * MiB, WS_END = 506 * MiB;
static_assert(W_END <= WS_PB && WS_ACT + (size_t)T_ROWS * FF * 2 <= WS_MIX, "ws map");
constexpr int RING_BYTES = 131072, LDSCTL_OFF = RING_BYTES, LDS_BYTES = 147456;

typedef unsigned short bf16;
typedef float f32x4 __attribute__((ext_vector_type(4)));
typedef unsigned u32x4v __attribute__((ext_vector_type(4)));
typedef unsigned u32x2v __attribute__((ext_vector_type(2)));
#define LAS __attribute__((address_space(3)))
__device__ __forceinline__ unsigned f2bf(float f) { unsigned u = __builtin_bit_cast(unsigned, f); return (u + 0x7fffu + ((u >> 16) & 1u)) >> 16; }
__device__ __forceinline__ unsigned pk2(float lo, float hi) { return f2bf(lo) | (f2bf(hi) << 16); }
__device__ __forceinline__ float bf2f(unsigned short b) { return __uint_as_float((unsigned)b << 16); }
__device__ __forceinline__ float wave_sum(float v) {
#pragma unroll
    for (int o = 1; o < 64; o <<= 1) v += __shfl_xor(v, o);
    return v;
}
#define LDS_WAIT() asm volatile("s_waitcnt lgkmcnt(0)" ::: "memory")
#define XB_TMO      128
#define XB_XCNT(j)  (256  + 64 * (j))
#define XB_XSUB(j)  (1280 + 64 * (j))
#define XB_XGEN(j)  (2304 + 64 * (j))
#define XB_TOP      3328
#define XB_TOPGEN   3392
#define XCD_BAR_WORDS 3456
#define XB_SPIN_CAP (1u << 18)

__device__ __forceinline__ unsigned xb_ld(unsigned* p)              { return __hip_atomic_load(p, __ATOMIC_RELAXED, __HIP_MEMORY_SCOPE_AGENT); }
__device__ __forceinline__ unsigned xb_add(unsigned* p, unsigned v) { return __hip_atomic_fetch_add(p, v, __ATOMIC_RELAXED, __HIP_MEMORY_SCOPE_AGENT); }
__device__ __forceinline__ unsigned xb_xcc_id() { return (unsigned)__builtin_amdgcn_s_getreg((3 << 11) | 20) & 0xFu; }
#define XB_SPIN(cond, bar) do { unsigned _sp = 0; while (cond) { __builtin_amdgcn_s_sleep(1); \
    if ((++_sp & 255u) == 0u) { if (xb_ld(&(bar)[XB_TMO])) break; if (_sp > XB_SPIN_CAP) { atomicAdd(&(bar)[XB_TMO], 1u); break; } } } } while (0)

struct XcdBarrier {
    unsigned* bar; unsigned x;
    volatile LAS unsigned* st;
};

__device__ __forceinline__ XcdBarrier xcd_barrier_post(unsigned* bar, volatile LAS unsigned* st) {
    XcdBarrier b; b.bar = bar; b.x = xb_xcc_id(); b.st = st;
    if (threadIdx.x == 0) (void)xb_add(&bar[XB_XCNT(b.x)], 1u);
    return b;
}
__device__ __forceinline__ void xcd_barrier_complete(unsigned* bar, unsigned x, unsigned& nloc, unsigned& nx) {
    const unsigned G = gridDim.x * gridDim.y * gridDim.z;
    unsigned sum, cnt, mine, sp = 0u;
    for (;;) {
        sum = 0u; cnt = 0u; mine = 0u;
#pragma unroll
        for (unsigned j = 0; j < 16; ++j) { const unsigned c = xb_ld(&bar[XB_XCNT(j)]); sum += c; cnt += (c > 0u) ? 1u : 0u; mine = (j == x) ? c : mine; }
        if (sum == G) break;
        __builtin_amdgcn_s_sleep(1);
        if ((++sp & 255u) == 0u) { if (xb_ld(&bar[XB_TMO])) break; if (sp > XB_SPIN_CAP) { atomicAdd(&bar[XB_TMO], 1u); break; } }
    }
    nloc = mine > 0u ? mine : 1u; nx = cnt > 0u ? cnt : 1u;
}

__device__ __forceinline__ void xcd_barrier(const XcdBarrier& b) {
    asm volatile("s_waitcnt vmcnt(0)" ::: "memory");
    __syncthreads();
    if (threadIdx.x == 0) {
        unsigned* bar = b.bar;
        __builtin_amdgcn_s_waitcnt(0);
        unsigned nloc = b.st[0], nx = b.st[1];
        if (nloc == 0u) { xcd_barrier_complete(bar, b.x, nloc, nx); b.st[0] = nloc; b.st[1] = nx; }
        const unsigned old = xb_add(&bar[XB_XSUB(b.x)], 1u);
        const unsigned gen = old / nloc;
        if (old + 1u == (gen + 1u) * nloc) {
            __builtin_amdgcn_fence(__ATOMIC_RELEASE, "agent");
            asm volatile("s_waitcnt vmcnt(0)" ::: "memory");
            const unsigned og = xb_add(&bar[XB_TOP], 1u);
            const unsigned tg = og / nx;
            if (og + 1u == (tg + 1u) * nx) xb_add(&bar[XB_TOPGEN], 1u);
            else XB_SPIN(xb_ld(&bar[XB_TOPGEN]) == tg, bar);
            __builtin_amdgcn_fence(__ATOMIC_ACQUIRE, "agent");
            xb_add(&bar[XB_XGEN(b.x)], 1u);
            asm volatile("s_waitcnt vmcnt(0)" ::: "memory");
        } else {
            XB_SPIN(xb_ld(&bar[XB_XGEN(b.x)]) == gen, bar);
            __builtin_amdgcn_fence(__ATOMIC_ACQUIRE, "agent");
            asm volatile("s_waitcnt vmcnt(0)" ::: "memory");
        }
    }
    __syncthreads();
}

constexpr int CW_TEAM = 4096, CW_TMASK = CW_TEAM + 128 * 64;
constexpr int CW_XG = CW_TMASK + 128 * 64, CW_XGMASK = CW_XG + 8 * 64;
constexpr int CW_GRID = CW_XGMASK + 8 * 64;
constexpr size_t CTL_MEMSET_BYTES = (size_t)(CW_GRID + 64) * 4;
__device__ __forceinline__ void team_barrier(unsigned* ctl, int key, unsigned target, bool need_release, int cw_base = CW_TEAM) {
    asm volatile("s_waitcnt vmcnt(0)" ::: "memory");
    __syncthreads();
    if (threadIdx.x == 0) {
        if (need_release) { __builtin_amdgcn_fence(__ATOMIC_RELEASE, "agent"); asm volatile("s_waitcnt vmcnt(0)" ::: "memory"); }
        unsigned* cnt = ctl + cw_base + 64 * key;
        (void)__hip_atomic_fetch_add(cnt, 1u, __ATOMIC_RELAXED, __HIP_MEMORY_SCOPE_AGENT);
        unsigned sp = 0;
        while (__hip_atomic_load(cnt, __ATOMIC_RELAXED, __HIP_MEMORY_SCOPE_AGENT) < target) { __builtin_amdgcn_s_sleep(1); if (++sp > (1u << 22)) break; }
        __builtin_amdgcn_fence(__ATOMIC_ACQUIRE, "agent");
        asm volatile("s_waitcnt vmcnt(0)" ::: "memory");
    }
    __syncthreads();
}
__device__ __forceinline__ void hook_wait(unsigned* ctl, int key, unsigned target, int cw_base) {
    if (threadIdx.x == 0) { unsigned* cnt = ctl + cw_base + 64 * key; unsigned sp = 0;
        while (__hip_atomic_load(cnt, __ATOMIC_RELAXED, __HIP_MEMORY_SCOPE_AGENT) < target) { __builtin_amdgcn_s_sleep(1); if (++sp > (1u << 22)) break; }
        __builtin_amdgcn_fence(__ATOMIC_ACQUIRE, "agent");
        asm volatile("s_waitcnt vmcnt(0)" ::: "memory"); }
    asm volatile("" ::: "memory"); __builtin_amdgcn_s_barrier(); asm volatile("" ::: "memory");
}
__device__ __forceinline__ void group_arrive(unsigned* ctl, int key, bool need_release, int cw_base) {
    asm volatile("s_waitcnt vmcnt(0)" ::: "memory");
    __syncthreads();
    if (threadIdx.x == 0) {
        if (need_release) { __builtin_amdgcn_fence(__ATOMIC_RELEASE, "agent"); asm volatile("s_waitcnt vmcnt(0)" ::: "memory"); }
        (void)__hip_atomic_fetch_add(ctl + cw_base + 64 * key, 1u, __ATOMIC_RELAXED, __HIP_MEMORY_SCOPE_AGENT); }
}
__device__ __forceinline__ void group_wait(unsigned* ctl, int key, unsigned target, int cw_base) {
    if (threadIdx.x == 0) { unsigned* cnt = ctl + cw_base + 64 * key; unsigned sp = 0;
        while (__hip_atomic_load(cnt, __ATOMIC_RELAXED, __HIP_MEMORY_SCOPE_AGENT) < target) { __builtin_amdgcn_s_sleep(1); if (++sp > (1u << 22)) break; }
        __builtin_amdgcn_fence(__ATOMIC_ACQUIRE, "agent");
        asm volatile("s_waitcnt vmcnt(0)" ::: "memory"); }
    __syncthreads();
}
__device__ __forceinline__ void p0_item(int kind, const float* a, const float* b, int ldn, const float* gain, int K, bf16* WT, int nblk, int item, int lane) {
    const int kb = item / nblk, nb = item % nblk, k0 = 64 * kb + 8 * (lane >> 3), P = 32 * nb + 4 * (lane & 7);
    const float* base = a; int col = P;
    if (kind == 1) { const int pn = P >> 8, bj = (P >> 7) & 1, q = P & 127; base = bj ? b : a; col = 128 * pn + q; }
    else if (kind == 2) { const int pn = P >> 8, p = P & 255, bj = p >> 7, wc = (p >> 5) & 3, r = p & 31, l = 256 * pn + 64 * wc + 32 * bj + r;
        if (l < 1792) col = l; else if (l < 2304) col = 1808 + (l - 1792); else if (l < 2320) col = 1792 + (l - 2304); else base = nullptr; }
    f32x4 v[8];
#pragma unroll
    for (int j = 0; j < 8; ++j) v[j] = base ? *(const f32x4*)(base + (size_t)(k0 + j) * ldn + col) : (f32x4){0.f, 0.f, 0.f, 0.f};
    if (gain) { const f32x4 g0 = *(const f32x4*)(gain + k0), g1 = *(const f32x4*)(gain + k0 + 4);
#pragma unroll
        for (int j = 0; j < 4; ++j) { v[j] = v[j] * g0[j]; v[4 + j] = v[4 + j] * g1[j]; } }
#pragma unroll
    for (int i = 0; i < 4; ++i) { u32x4v o; o.x = pk2(v[0][i], v[1][i]); o.y = pk2(v[2][i], v[3][i]); o.z = pk2(v[4][i], v[5][i]); o.w = pk2(v[6][i], v[7][i]);
        pg8::st16_wt(WT + (size_t)(P + i) * K + k0, o); }
}
struct Args { const float* in[23]; float* out; unsigned char* ws; int ph_lo, ph_hi; };
static_assert(sizeof(Args) == 26 * 8, "Args has no padding");

__device__ __forceinline__ void phase_prologue(const Args& A, LAS unsigned char* lds, int wave, int lane) {
    unsigned char* ws = A.ws;
    const int gw = blockIdx.x * NWAVES + wave, NGW = gridDim.x * NWAVES;
    constexpr int I_GU = (DM / 64) * (NGU / 32), I_D = (FF / 64) * (DM / 32), I_IN = (DM / 64) * (NIN / 32), I_SQ = (DM / 64) * (DM / 32), I_PP = (PLE / 64) * (DM / 32);
    constexpr int NITEMS = 2 * I_GU + 2 * I_D + I_IN + 2 * I_SQ + I_PP;
    for (int rp_ = 0; rp_ < (((PROBE_MASK) >> 23) & 1 ? 2 : 1); ++rp_)
    for (int it = gw; it < NITEMS; it += NGW) {
        int r = it;
        if (r < I_GU) { p0_item(1, A.in[3], A.in[4], FF, A.in[2], DM, (bf16*)(ws + W_1GU), NGU / 32, r, lane); continue; } r -= I_GU;
        if (r < I_GU) { p0_item(1, A.in[16], A.in[17], FF, A.in[15], DM, (bf16*)(ws + W_2GU), NGU / 32, r, lane); continue; } r -= I_GU;
        if (r < I_D) { p0_item(0, A.in[5], nullptr, DM, nullptr, FF, (bf16*)(ws + W_1D), DM / 32, r, lane); continue; } r -= I_D;
        if (r < I_D) { p0_item(0, A.in[18], nullptr, DM, nullptr, FF, (bf16*)(ws + W_2D), DM / 32, r, lane); continue; } r -= I_D;
        if (r < I_IN) { p0_item(2, A.in[7], nullptr, 2320, A.in[6], DM, (bf16*)(ws + W_IN), NIN / 32, r, lane); continue; } r -= I_IN;
        if (r < I_SQ) { p0_item(0, A.in[14], nullptr, DM, nullptr, DM, (bf16*)(ws + W_OUT), DM / 32, r, lane); continue; } r -= I_SQ;
        if (r < I_SQ) { p0_item(0, A.in[20], nullptr, DM, A.in[19], DM, (bf16*)(ws + W_PG), DM / 32, r, lane); continue; } r -= I_SQ;
        p0_item(0, A.in[21], nullptr, DM, nullptr, PLE, (bf16*)(ws + W_PP), DM / 32, r, lane);
    }
    float* cosT = (float*)(ws + WS_TAB); float* sinT = cosT + SEQ * 32;
    for (int e = (blockIdx.x * NWAVES + wave) * 64 + lane; e < SEQ * 32; e += gridDim.x * NWAVES * 64) { const int pos = e >> 5, i = e & 31;
        const float inv = exp2f(-(float)(2 * i) * (1.0f / 64.0f) * 13.287712379549449f);
        const float ang = (float)pos * inv; const double rev = (double)ang * 0.15915494309189535; const float fr = (float)(rev - __builtin_floor(rev));
        __hip_atomic_store((unsigned*)(cosT + e), __float_as_uint(__builtin_amdgcn_cosf(fr)), __ATOMIC_RELAXED, __HIP_MEMORY_SCOPE_AGENT); __hip_atomic_store((unsigned*)(sinT + e), __float_as_uint(__builtin_amdgcn_sinf(fr)), __ATOMIC_RELAXED, __HIP_MEMORY_SCOPE_AGENT); }
}
__device__ __forceinline__ void phase_prologue_team(const Args& A, int team_key, int wave, int lane) {
    unsigned char* ws = A.ws; const float* x = A.in[0]; bf16* XB = (bf16*)(ws + WS_XB); float* ssq0 = (float*)(ws + WS_SSQ);
    const int q = ((int)blockIdx.x >> 3) >> 3, rbase = team_key * 256 + 64 * q + 8 * wave;
#pragma unroll 1
    for (int t = 0; t < 8; ++t) {
        f32x4 v[2][2][2]; float sq[2];
#pragma unroll
        for (int r = 0; r < 2; ++r) { const f32x4* xr = (const f32x4*)(x + (size_t)(rbase + t + r * 2048) * DM) + 2 * lane;
#pragma unroll
            for (int j = 0; j < 2; ++j) { v[r][j][0] = xr[128 * j]; v[r][j][1] = xr[128 * j + 1]; } }
#pragma unroll
        for (int r = 0; r < 2; ++r) { float s = 0.f;
#pragma unroll
            for (int j = 0; j < 2; ++j)
#pragma unroll
                for (int h = 0; h < 2; ++h) { const f32x4 tt = v[r][j][h]; s += (tt[0] * tt[0] + tt[1] * tt[1]) + (tt[2] * tt[2] + tt[3] * tt[3]); }
            sq[r] = wave_sum(s);
            u32x4v* o16 = (u32x4v*)(XB + (size_t)(rbase + t + r * 2048) * DM) + lane;
#pragma unroll
            for (int j = 0; j < 2; ++j) { u32x4v w; w.x = pk2(v[r][j][0][0], v[r][j][0][1]); w.y = pk2(v[r][j][0][2], v[r][j][0][3]); w.z = pk2(v[r][j][1][0], v[r][j][1][1]); w.w = pk2(v[r][j][1][2], v[r][j][1][3]); o16[64 * j] = w; } }
        if (lane == 0) { ssq0[rbase + t] = sq[0]; ssq0[rbase + t + 2048] = sq[1]; }
    }
    const float* p = A.in[1]; bf16* PB = (bf16*)(ws + WS_PB); const int half = lane >> 5, l5 = lane & 31;
#pragma unroll 1
    for (int t0 = 0; t0 < 8; t0 += 4) { f32x4 v[4][2];
#pragma unroll
        for (int j = 0; j < 4; ++j) { const f32x4* pr = (const f32x4*)(p + (size_t)(rbase + t0 + j + half * 2048) * PLE) + 2 * l5; v[j][0] = pr[0]; v[j][1] = pr[1]; }
#pragma unroll
        for (int j = 0; j < 4; ++j) { u32x4v w; w.x = pk2(v[j][0][0], v[j][0][1]); w.y = pk2(v[j][0][2], v[j][0][3]); w.z = pk2(v[j][1][0], v[j][1][1]); w.w = pk2(v[j][1][2], v[j][1][3]);
            *((u32x4v*)(PB + (size_t)(rbase + t0 + j + half * 2048) * PLE) + l5) = w; } }
}

namespace swa {
typedef float f32x16 __attribute__((ext_vector_type(16)));
typedef short bf16x8 __attribute__((ext_vector_type(8)));
typedef short s16x4 __attribute__((ext_vector_type(4)));
typedef unsigned u32x4 __attribute__((ext_vector_type(4)));
constexpr int LK = 0, LV = 32768, LST = 65536, LWS = 98304, LDS_END = LWS + 8 * 256;
constexpr float LOG2E = 1.4426950408889634f;
__device__ __forceinline__ int crow(int r, int hi) { return (r & 3) + 8 * (r >> 2) + 4 * hi; }
__device__ __forceinline__ s16x4 vtr(LAS const unsigned char* p) { return __builtin_bit_cast(s16x4, __builtin_amdgcn_ds_read_tr16_b64_v4i16((LAS s16x4*)p)); }
__device__ __forceinline__ unsigned cvtpk(float lo, float hi) { typedef float f2 __attribute__((ext_vector_type(2))); typedef __bf16 b2 __attribute__((ext_vector_type(2))); f2 v = {lo, hi}; b2 b = __builtin_convertvector(v, b2); return __builtin_bit_cast(unsigned, b); }
__device__ __forceinline__ float xhalf_max(float m) { auto rr = __builtin_amdgcn_permlane32_swap(__float_as_uint(m), __float_as_uint(m), false, false); return fmaxf(__uint_as_float(rr[0]), __uint_as_float(rr[1])); }
__device__ __forceinline__ float xhalf_sum(float m) { auto rr = __builtin_amdgcn_permlane32_swap(__float_as_uint(m), __float_as_uint(m), false, false); return __uint_as_float(rr[0]) + __uint_as_float(rr[1]); }

struct KVRegs { u32x4 k[4], v[4]; };
__device__ __forceinline__ void kv_load(KVRegs& R, const bf16* Z, int u) {
    const int tid = threadIdx.x, n = u & 31, kvh = (u >> 5) & 1, b = u >> 6; const long rowb = (long)b * SEQ + (long)(n - 1) * 128;
#pragma unroll
    for (int i = 0; i < 4; ++i) { const int e = tid + 512 * i, key = e >> 3, c = e & 7; R.k[i] = (u32x4){0u, 0u, 0u, 0u}; R.v[i] = R.k[i];
        if (n > 0 || key >= 128) { const bf16* rp = Z + pg8::zoff((int)(rowb + key)) + 64 * kvh + 8 * c; R.k[i] = *(const u32x4*)(rp + ZC_AK); R.v[i] = *(const u32x4*)(rp + ZC_AV); } }
}
__device__ __forceinline__ void attn_phase(const bf16* Z, bf16* MIX, const float* sinks, LAS unsigned char* lds) {
    const int tid = threadIdx.x, lane = tid & 63, l31 = lane & 31, hi = lane >> 5, wave = __builtin_amdgcn_readfirstlane(tid >> 6), G = gridDim.x;
    LAS float* wsf = (LAS float*)(lds + LWS + wave * 256); LAS unsigned short* stg = (LAS unsigned short*)(lds + LST + wave * 4096);
    const int kswz = (l31 >> 1) & 7, g = wave >> 1, s = wave & 1;
    LAS const unsigned char* vbase = lds + LV + (4 * hi + ((lane & 15) >> 2)) * 64 + (16 * ((lane >> 4) & 1) + 4 * (lane & 3)) * 2;
    const int ub = (int)(blockIdx.x & 7) * 64, ui0 = (int)(blockIdx.x >> 3), UI = G >> 3;
    int ui = ui0; KVRegs kv; if (ui < 64) kv_load(kv, Z, ub + ui);
#pragma unroll 1
    for (; ui < 64; ui += UI) { const int u = ub + ui, n = u & 31, kvh = (u >> 5) & 1, b = u >> 6, head = 4 * kvh + g;
#pragma unroll
        for (int i = 0; i < 4; ++i) { const int e = tid + 512 * i, key = e >> 3, c = e & 7;
            *(LAS u32x4*)(lds + LK + key * 128 + ((c ^ ((key >> 1) & 7)) << 4)) = kv.k[i];
            *(LAS u32x4*)(lds + LV + (c >> 2) * 16384 + key * 64 + (c & 3) * 16) = kv.v[i]; }
        const size_t qrowb = (size_t)b * SEQ + (size_t)n * 128 + 64 * s;
        bf16x8 qn[4];
#pragma unroll
        for (int ks = 0; ks < 4; ++ks) qn[ks] = *(const bf16x8*)(Z + pg8::zoff((int)(qrowb + l31)) + ZC_AQ + 64 * head + 16 * ks + 8 * hi);
        const float sink2 = sinks[head] * LOG2E;
        { const int uin = ui + UI; if (uin < 64) kv_load(kv, Z, ub + uin); }
        __syncthreads();
#pragma unroll 1
        for (int qb2 = 0; qb2 < 2; ++qb2) {
            const int kb0 = 2 * s + qb2, qi0 = 32 * kb0; const size_t qrow0 = qrowb + 32 * qb2;
            bf16x8 qf[4];
#pragma unroll
            for (int ks = 0; ks < 4; ++ks) qf[ks] = qn[ks];
            if (qb2 == 0) {
#pragma unroll
                for (int ks = 0; ks < 4; ++ks) qn[ks] = *(const bf16x8*)(Z + pg8::zoff((int)(qrowb + 32 + l31)) + ZC_AQ + 64 * head + 16 * ks + 8 * hi); }
            f32x16 st[5];
#pragma unroll
            for (int kb = 0; kb < 5; ++kb) { st[kb] = (f32x16){};
#pragma unroll
                for (int ks = 0; ks < 4; ++ks) { const bf16x8 kf = *(LAS const bf16x8*)(lds + LK + (32 * (kb0 + kb) + l31) * 128 + (((2 * ks + hi) ^ kswz) << 4));
                    st[kb] = __builtin_amdgcn_mfma_f32_32x32x16_bf16(kf, qf[ks], st[kb], 0, 0, 0); } }
            float mx = sink2;
#pragma unroll
            for (int kb = 0; kb < 5; ++kb)
#pragma unroll
                for (int r = 0; r < 16; ++r) { const int cr = crow(r, hi); bool valid = true;
                    if (kb == 0) valid = cr > l31; if (kb == 4) valid = cr <= l31;
                    if (kb == 0 || kb == 4) st[kb][r] = valid ? st[kb][r] : -INFINITY; }
            if (n == 0) {
#pragma unroll
                for (int kb = 0; kb < 5; ++kb)
#pragma unroll
                    for (int r = 0; r < 16; ++r) st[kb][r] = (qi0 + 32 * kb + crow(r, hi) >= 128) ? st[kb][r] : -INFINITY; }
#pragma unroll
            for (int kb = 0; kb < 5; ++kb)
#pragma unroll
                for (int r = 0; r < 16; ++r) { mx = fmaxf(mx, st[kb][r]); }
            mx = xhalf_max(mx);
            float l = 0.f;
#pragma unroll
            for (int kb = 0; kb < 5; ++kb)
#pragma unroll
                for (int r = 0; r < 16; ++r) { const float p = __builtin_amdgcn_exp2f(st[kb][r] - mx); st[kb][r] = p; l += p; }
            l = xhalf_sum(l) + __builtin_amdgcn_exp2f(sink2 - mx);
            f32x16 o[2]; o[0] = (f32x16){}; o[1] = (f32x16){};
#pragma unroll
            for (int kb = 0; kb < 5; ++kb)
#pragma unroll
                for (int s2 = 0; s2 < 2; ++s2) { u32x4 pw; pw.x = cvtpk(st[kb][8 * s2 + 0], st[kb][8 * s2 + 1]); pw.y = cvtpk(st[kb][8 * s2 + 2], st[kb][8 * s2 + 3]); pw.z = cvtpk(st[kb][8 * s2 + 4], st[kb][8 * s2 + 5]); pw.w = cvtpk(st[kb][8 * s2 + 6], st[kb][8 * s2 + 7]);
                    const bf16x8 pa = __builtin_bit_cast(bf16x8, pw); const int key0 = 32 * (kb0 + kb) + 16 * s2;
#pragma unroll
                    for (int d0 = 0; d0 < 2; ++d0) { const s16x4 lo = vtr(vbase + d0 * 16384 + key0 * 64), hh = vtr(vbase + d0 * 16384 + (key0 + 8) * 64);
                        const bf16x8 vb = {lo[0], lo[1], lo[2], lo[3], hh[0], hh[1], hh[2], hh[3]};
                        o[d0] = __builtin_amdgcn_mfma_f32_32x32x16_bf16(pa, vb, o[d0], 0, 0, 0); } }
            if (hi == 0) wsf[l31] = __builtin_amdgcn_rcpf(l);
            asm volatile("s_waitcnt lgkmcnt(0)" ::: "memory");
#pragma unroll
            for (int r = 0; r < 16; ++r) { const int q = crow(r, hi); const float il = wsf[q];
#pragma unroll
                for (int d0 = 0; d0 < 2; ++d0) stg[q * 64 + d0 * 32 + l31] = (unsigned short)cvtpk(o[d0][r] * il, 0.f); }
            asm volatile("s_waitcnt lgkmcnt(0)" ::: "memory");
#pragma unroll
            for (int i = 0; i < 4; ++i) { const int row = i * 8 + (lane >> 3), ch = lane & 7; const u32x4 v = *(LAS const u32x4*)(stg + row * 64 + ch * 8);
                *(u32x4*)(MIX + (qrow0 + row) * DM + 64 * head + ch * 8) = v; }
            asm volatile("s_waitcnt lgkmcnt(0)" ::: "memory");
        }
        __syncthreads();
    }
}
}
namespace gla {
typedef float f32x16 __attribute__((ext_vector_type(16)));
typedef short bf16x8 __attribute__((ext_vector_type(8)));
typedef short s16x4 __attribute__((ext_vector_type(4)));
typedef unsigned u32x4 __attribute__((ext_vector_type(4)));
typedef unsigned u32x2 __attribute__((ext_vector_type(2)));
constexpr int GL_GLR = 0, GL_WU = 4096, GL_BIAS = 8192, GL_SEG = 8448, GL_B = 10496, GL_QT = 26880, GL_KT = 35072, GL_KH = 43264, GL_V = 51456, GL_S = 67840, GL_RS = 84224, GL_STG = 85248, STG_LD = 132, GL_END = GL_STG + 64 * STG_LD * 4;
static_assert(GL_END <= 131072, "GLA LDS map");
constexpr float LOG2E = 1.4426950408889634f;
__device__ __forceinline__ int crow(int r, int hi) { return (r & 3) + 8 * (r >> 2) + 4 * hi; }
__device__ __forceinline__ s16x4 vtr(LAS const unsigned char* p) { return __builtin_bit_cast(s16x4, __builtin_amdgcn_ds_read_tr16_b64_v4i16((LAS s16x4*)p)); }
__device__ __forceinline__ bf16x8 tr2(LAS const unsigned char* p, int second_off) { const s16x4 a = vtr(p), b = vtr(p + second_off); return (bf16x8){a[0], a[1], a[2], a[3], b[0], b[1], b[2], b[3]}; }
__device__ __forceinline__ unsigned cvtpk(float lo, float hi) { typedef float f2 __attribute__((ext_vector_type(2))); typedef __bf16 b2 __attribute__((ext_vector_type(2))); f2 v = {lo, hi}; b2 b = __builtin_convertvector(v, b2); return __builtin_bit_cast(unsigned, b); }
__device__ __forceinline__ float xhalf_sum(float m) { auto rr = __builtin_amdgcn_permlane32_swap(__float_as_uint(m), __float_as_uint(m), false, false); return __uint_as_float(rr[0]) + __uint_as_float(rr[1]); }
__device__ __forceinline__ float bflo(unsigned w) { return __uint_as_float(w << 16); }
__device__ __forceinline__ float bfhi(unsigned w) { return __uint_as_float(w & 0xffff0000u); }
typedef _Float16 h16x2 __attribute__((ext_vector_type(2)));
__device__ __forceinline__ unsigned pkh(float a, float b) { typedef float f2 __attribute__((ext_vector_type(2))); const f2 v = {a, b}; const h16x2 h = __builtin_convertvector(v, h16x2); return __builtin_bit_cast(unsigned, h); }
__device__ __forceinline__ f32x4 unh4(unsigned w0, unsigned w1) { const h16x2 a = __builtin_bit_cast(h16x2, w0), b = __builtin_bit_cast(h16x2, w1); return (f32x4){(float)a[0], (float)a[1], (float)b[0], (float)b[1]}; }

__device__ __forceinline__ size_t bt_off(int u) { return (size_t)(u >> 8) * (4096 * 1024) + (size_t)(u & 255) * 4096; }
__device__ __forceinline__ size_t gg_off(int g) { return (size_t)(g >> 5) * (4096 * 1024) + (size_t)256 * 4096 + (size_t)(g & 31) * 8192; }
__device__ __forceinline__ void gates(LAS unsigned char* lds, const float (&wcol)[16], float bz) {
    const int tid = threadIdx.x;
    LAS float* gl = (LAS float*)(lds + GL_GLR); LAS float* seg = (LAS float*)(lds + GL_SEG); LAS float* bt = (LAS float*)(lds + GL_B);
    const int dk = tid & 63, sg = tid >> 6; float run = 0.f, cs[8];
#pragma unroll
    for (int i = 0; i < 8; ++i) { const int tok = 8 * sg + i; float z = bz;
#pragma unroll
        for (int r = 0; r < 16; ++r) z += gl[tok * 16 + r] * wcol[r];
        const float e = __builtin_amdgcn_exp2f(-fabsf(z) * LOG2E);
        const float g2 = (fminf(z, 0.f) * LOG2E - __builtin_amdgcn_logf(1.0f + e)) * (1.0f / 16.0f);
        run += g2; cs[i] = run; }
    seg[sg * 64 + dk] = run;
    __syncthreads();
    float off = 0.f;
#pragma unroll
    for (int s = 0; s < 8; ++s) off += (s < sg) ? seg[s * 64 + dk] : 0.f;
#pragma unroll
    for (int i = 0; i < 8; ++i) bt[(8 * sg + i) * 64 + dk] = cs[i] + off;
    __syncthreads();
}
__device__ __forceinline__ void load_wcol(const float* Wup, const float* bgate, int hh, float (&wcol)[16], float& bz) {
    const int dk = threadIdx.x & 63;
#pragma unroll
    for (int r = 0; r < 16; ++r) wcol[r] = Wup[r * 256 + 64 * hh + dk];
    bz = bgate[64 * hh + dk];
}
struct ChunkRegs { u32x4 kw, qw, v[2], gog[2], sh[2], bh; unsigned glr; float dec; };
template <bool P3> __device__ __forceinline__ void chunk_load(ChunkRegs& R, const bf16* Z, const float* GS, const float* DEC_, const float* BT, int u) {
    const int tid = threadIdx.x, bh = u >> 6, c = u & 63, hh = bh & 3, row0 = (bh >> 2) * SEQ + c * 64, tok = tid >> 3, ch = tid & 7;
    const bf16* zr = Z + pg8::zoff(row0 + tok);
    R.kw = *(const u32x4*)(zr + ZC_GK + 64 * hh + 8 * ch);
    if (!P3) R.glr = *(const unsigned*)(zr + ZC_GLR + 2 * ch);
    if (P3) { R.qw = *(const u32x4*)(zr + ZC_GQ + 64 * hh + 8 * ch); R.bh = *(const u32x4*)((const _Float16*)(BT + bt_off(u)) + tok * 64 + 8 * ch); }
#pragma unroll
    for (int i = 0; i < 2; ++i) { const int e = tid + 512 * i, tk = e >> 4, cc = e & 15; R.v[i] = *(const u32x4*)(Z + pg8::zoff(row0 + tk) + ZC_GV + 128 * hh + 8 * cc);
        if (P3) R.gog[i] = *(const u32x4*)(Z + pg8::zoff(row0 + tk) + ZC_GOG + 128 * hh + 8 * cc); }
    if (P3) {
        { const u32x4* sp = (const u32x4*)((const _Float16*)GS + (size_t)u * 8192 + (tid >> 3) * 128 + (tid & 7) * 16); R.sh[0] = sp[0]; R.sh[1] = sp[1]; }
        R.dec = DEC_[(size_t)u * 64 + (tid >> 3)]; }
}
template <bool P3> __device__ __forceinline__ void chunk_stage(const ChunkRegs& R, LAS unsigned char* lds) {
    const int tid = threadIdx.x; LAS float* gl = (LAS float*)(lds + GL_GLR);
    if (!P3) { gl[(tid >> 3) * 16 + (tid & 7) * 2] = bflo(R.glr); gl[(tid >> 3) * 16 + (tid & 7) * 2 + 1] = bfhi(R.glr); }
#pragma unroll
    for (int i = 0; i < 2; ++i) { const int e = tid + 512 * i, tk = e >> 4, cc = e & 15; *(LAS u32x4*)(lds + GL_V + (cc >> 2) * 4096 + tk * 64 + (cc & 3) * 16) = R.v[i]; }
}
__device__ __forceinline__ void passA(const Args& A, LAS unsigned char* lds) {
    const bf16* Z = (const bf16*)(A.ws + WS_ACT); float* DEC = (float*)(A.ws + WS_DEC); float* AG = (float*)(A.ws + WS_AG); float* GS = (float*)(A.ws + WS_GS); float* BT = A.out; float* GG = A.out;
    const int tid = threadIdx.x, lane = tid & 63, l31 = lane & 31, hi = lane >> 5, wave = __builtin_amdgcn_readfirstlane(tid >> 6), G = gridDim.x;
    LAS float* bt = (LAS float*)(lds + GL_B);
    const int troff = (8 * hi + ((lane & 15) >> 2)) * 64 + (16 * ((lane >> 4) & 1) + 4 * (lane & 3)) * 2;
    const int dkb = wave & 1, db = wave >> 1, tok = tid >> 3, ch = tid & 7;
    float wcol[16], bz = 0.f; int hprev = -1;
    const int gb = (int)(blockIdx.x & 7) * 32, GI = G >> 3; int gi = (int)(blockIdx.x >> 3); ChunkRegs cur; if (gi < 32) chunk_load<false>(cur, Z, GS, DEC, BT, (gb + gi) * 8);
#pragma unroll 1
    for (; gi < 32; gi += GI) { const int g = gb + gi, hh = (g >> 3) & 3;
        if (hh != hprev) { load_wcol(A.in[11], A.in[12], hh, wcol, bz); hprev = hh; }
        f32x16 gacc = (f32x16){}; float bsum = 0.f;
#pragma unroll 1
        for (int j = 0; j < 8; ++j) { const int u = g * 8 + j;
            chunk_stage<false>(cur, lds);
            const u32x4 kw = cur.kw;
            { const int un = (j < 7) ? u + 1 : ((gi + GI < 32) ? (g + GI) * 8 : 2048); if (un < 2048) chunk_load<false>(cur, Z, GS, DEC, BT, un); }
            __syncthreads();
            gates(lds, wcol, bz);
            if (tid < 64) { const float bl = bt[63 * 64 + tid]; DEC[(size_t)u * 64 + tid] = __builtin_amdgcn_exp2f(bl); bsum += bl; }
            { const f32x4 b0 = *(LAS const f32x4*)(bt + tok * 64 + 8 * ch), b1 = *(LAS const f32x4*)(bt + tok * 64 + 8 * ch + 4), l0 = *(LAS const f32x4*)(bt + 63 * 64 + 8 * ch), l1 = *(LAS const f32x4*)(bt + 63 * 64 + 8 * ch + 4);
              { u32x4 hb; hb.x = pkh(b0[0], b0[1]); hb.y = pkh(b0[2], b0[3]); hb.z = pkh(b1[0], b1[1]); hb.w = pkh(b1[2], b1[3]); *(u32x4*)((_Float16*)(BT + bt_off(u)) + tok * 64 + 8 * ch) = hb; }
              u32x4 o; o.x = cvtpk(bflo(kw.x) * __builtin_amdgcn_exp2f(l0[0] - b0[0]), bfhi(kw.x) * __builtin_amdgcn_exp2f(l0[1] - b0[1])); o.y = cvtpk(bflo(kw.y) * __builtin_amdgcn_exp2f(l0[2] - b0[2]), bfhi(kw.y) * __builtin_amdgcn_exp2f(l0[3] - b0[3]));
              o.z = cvtpk(bflo(kw.z) * __builtin_amdgcn_exp2f(l1[0] - b1[0]), bfhi(kw.z) * __builtin_amdgcn_exp2f(l1[1] - b1[1])); o.w = cvtpk(bflo(kw.w) * __builtin_amdgcn_exp2f(l1[2] - b1[2]), bfhi(kw.w) * __builtin_amdgcn_exp2f(l1[3] - b1[3]));
              *(LAS u32x4*)(lds + GL_KH + (ch >> 2) * 4096 + tok * 64 + (ch & 3) * 16) = o; }
            __syncthreads();
            f32x16 acc = (f32x16){};
#pragma unroll
            for (int ks = 0; ks < 4; ++ks) { const bf16x8 a = tr2(lds + GL_KH + dkb * 4096 + ks * 1024 + troff, 256), b = tr2(lds + GL_V + db * 4096 + ks * 1024 + troff, 256);
                acc = __builtin_amdgcn_mfma_f32_32x32x16_bf16(b, a, acc, 0, 0, 0); }
            { _Float16* gp = (_Float16*)GS + (size_t)u * 8192 + (32 * dkb + l31) * 128 + 32 * db + 4 * hi; const float dg = __builtin_amdgcn_exp2f(bt[63 * 64 + 32 * dkb + l31]);
#pragma unroll
              for (int g4 = 0; g4 < 4; ++g4) { u32x2 w; w.x = pkh(acc[4 * g4], acc[4 * g4 + 1]); w.y = pkh(acc[4 * g4 + 2], acc[4 * g4 + 3]); *(u32x2*)(gp + 8 * g4) = w; }
              gacc = gacc * dg + acc; }
            __syncthreads(); }
        { _Float16* gq = (_Float16*)(GG + gg_off(g)) + (32 * dkb + l31) * 128 + 32 * db + 4 * hi;
#pragma unroll
          for (int g4 = 0; g4 < 4; ++g4) { u32x2 w; w.x = pkh(gacc[4 * g4], gacc[4 * g4 + 1]); w.y = pkh(gacc[4 * g4 + 2], gacc[4 * g4 + 3]); *(u32x2*)(gq + 8 * g4) = w; } }
        if (tid < 64) AG[(size_t)g * 64 + tid] = __builtin_amdgcn_exp2f(bsum); }
}
__device__ __forceinline__ void passB(const Args& A, LAS unsigned char* lds) {
    const bf16* Z = (const bf16*)(A.ws + WS_ACT); bf16* MIX = (bf16*)(A.ws + WS_MIX); const float* GS = (const float*)(A.ws + WS_GS); const float* gon = A.in[13];
    const float* DEC = (const float*)(A.ws + WS_DEC); const float* AG = (const float*)(A.ws + WS_AG); const float* BT = A.out; const float* GG = A.out;
    const int tid = threadIdx.x, lane = tid & 63, l31 = lane & 31, hi = lane >> 5, wave = __builtin_amdgcn_readfirstlane(tid >> 6), G = gridDim.x;
    LAS float* rs = (LAS float*)(lds + GL_RS); LAS float* stg = (LAS float*)(lds + GL_STG);
    const int trcol = (16 * ((lane >> 4) & 1) + 4 * (lane & 3)) * 2, trq = (lane & 15) >> 2;
    const int troff_nat = (8 * hi + trq) * 64 + trcol;
    const int troff_acc = (4 * hi + trq) * 64 + trcol;
    const int tok = tid >> 3, ch = tid & 7;
    const int gb = (int)(blockIdx.x & 7) * 32, GI = G >> 3; int gi = (int)(blockIdx.x >> 3); ChunkRegs cur; if (gi < 32) chunk_load<true>(cur, Z, GS, DEC, BT, (gb + gi) * 8);
#pragma unroll 1
    for (; gi < 32; gi += GI) { const int g = gb + gi;
      f32x4 S[4]; S[0] = S[1] = S[2] = S[3] = (f32x4){0.f, 0.f, 0.f, 0.f};
      { const int gfirst = g & ~7;
#pragma unroll 1
        for (int g2 = gfirst; g2 < g; ++g2) { const float a = AG[(size_t)g2 * 64 + tok]; const u32x4* gp = (const u32x4*)((const _Float16*)(GG + gg_off(g2)) + tok * 128 + ch * 16); const u32x4 g0 = gp[0], g1 = gp[1];
            S[0] = S[0] * a + unh4(g0.x, g0.y); S[1] = S[1] * a + unh4(g0.z, g0.w); S[2] = S[2] * a + unh4(g1.x, g1.y); S[3] = S[3] * a + unh4(g1.z, g1.w); } }
#pragma unroll 1
      for (int j = 0; j < 8; ++j) { const int u = g * 8 + j, bh = u >> 6, c = u & 63, hh = bh & 3, row0 = (bh >> 2) * SEQ + c * 64;
        chunk_stage<true>(cur, lds);
        { u32x4 w0, w1; w0.x = cvtpk(S[0][0], S[0][1]); w0.y = cvtpk(S[0][2], S[0][3]); w0.z = cvtpk(S[1][0], S[1][1]); w0.w = cvtpk(S[1][2], S[1][3]); w1.x = cvtpk(S[2][0], S[2][1]); w1.y = cvtpk(S[2][2], S[2][3]); w1.z = cvtpk(S[3][0], S[3][1]); w1.w = cvtpk(S[3][2], S[3][3]);
          LAS unsigned char* sp = lds + GL_S + (ch >> 1) * 4096 + tok * 64 + (ch & 1) * 32; *(LAS u32x4*)sp = w0; *(LAS u32x4*)(sp + 16) = w1; }
        const u32x4 kw = cur.kw, qw = cur.qw, gog0 = cur.gog[0], gog1 = cur.gog[1]; const f32x4 b0 = unh4(cur.bh.x, cur.bh.y), b1 = unh4(cur.bh.z, cur.bh.w);
        { const u32x4 s0 = cur.sh[0], s1 = cur.sh[1]; const float dc = cur.dec;
          S[0] = S[0] * dc + unh4(s0.x, s0.y); S[1] = S[1] * dc + unh4(s0.z, s0.w); S[2] = S[2] * dc + unh4(s1.x, s1.y); S[3] = S[3] * dc + unh4(s1.z, s1.w); }
        { const int un = (j < 7) ? u + 1 : ((gi + GI < 32) ? (g + GI) * 8 : 2048); if (un < 2048) chunk_load<true>(cur, Z, GS, DEC, BT, un); }
        { float ep[8], em[8];
#pragma unroll
          for (int j = 0; j < 4; ++j) { ep[j] = __builtin_amdgcn_exp2f(b0[j]); ep[4 + j] = __builtin_amdgcn_exp2f(b1[j]); em[j] = __builtin_amdgcn_exp2f(-b0[j]); em[4 + j] = __builtin_amdgcn_exp2f(-b1[j]); }
          u32x4 oq, ok; oq.x = cvtpk(bflo(qw.x) * ep[0], bfhi(qw.x) * ep[1]); oq.y = cvtpk(bflo(qw.y) * ep[2], bfhi(qw.y) * ep[3]); oq.z = cvtpk(bflo(qw.z) * ep[4], bfhi(qw.z) * ep[5]); oq.w = cvtpk(bflo(qw.w) * ep[6], bfhi(qw.w) * ep[7]);
          ok.x = cvtpk(bflo(kw.x) * em[0], bfhi(kw.x) * em[1]); ok.y = cvtpk(bflo(kw.y) * em[2], bfhi(kw.y) * em[3]); ok.z = cvtpk(bflo(kw.z) * em[4], bfhi(kw.z) * em[5]); ok.w = cvtpk(bflo(kw.w) * em[6], bfhi(kw.w) * em[7]);
          const int sw = (ch ^ ((tok >> 1) & 7)) << 4;
          *(LAS u32x4*)(lds + GL_QT + tok * 128 + sw) = oq; *(LAS u32x4*)(lds + GL_KT + tok * 128 + sw) = ok; }
        __syncthreads();
        const int ib = wave & 1, db = wave >> 1, kswz = (l31 >> 1) & 7;
        bf16x8 qb[4];
#pragma unroll
        for (int ks = 0; ks < 4; ++ks) qb[ks] = *(LAS const bf16x8*)(lds + GL_QT + (32 * ib + l31) * 128 + (((2 * ks + hi) ^ kswz) << 4));
        f32x16 o = (f32x16){};
#pragma unroll
        for (int jb = 0; jb < 2; ++jb) { if (jb <= ib) {
            f32x16 x = (f32x16){};
#pragma unroll
            for (int ks = 0; ks < 4; ++ks) { const bf16x8 kf = *(LAS const bf16x8*)(lds + GL_KT + (32 * jb + l31) * 128 + (((2 * ks + hi) ^ kswz) << 4)); x = __builtin_amdgcn_mfma_f32_32x32x16_bf16(kf, qb[ks], x, 0, 0, 0); }
            if (jb == ib) {
#pragma unroll
                for (int r = 0; r < 16; ++r) x[r] = (crow(r, hi) <= l31) ? x[r] : 0.f; }
#pragma unroll
            for (int s2 = 0; s2 < 2; ++s2) { u32x4 pw; pw.x = cvtpk(x[8 * s2 + 0], x[8 * s2 + 1]); pw.y = cvtpk(x[8 * s2 + 2], x[8 * s2 + 3]); pw.z = cvtpk(x[8 * s2 + 4], x[8 * s2 + 5]); pw.w = cvtpk(x[8 * s2 + 6], x[8 * s2 + 7]);
                const bf16x8 va = tr2(lds + GL_V + db * 4096 + (32 * jb + 16 * s2) * 64 + troff_acc, 512);
                o = __builtin_amdgcn_mfma_f32_32x32x16_bf16(va, __builtin_bit_cast(bf16x8, pw), o, 0, 0, 0); } } }
#pragma unroll
        for (int ks = 0; ks < 4; ++ks) { const bf16x8 sa = tr2(lds + GL_S + db * 4096 + ks * 1024 + troff_nat, 256); o = __builtin_amdgcn_mfma_f32_32x32x16_bf16(sa, qb[ks], o, 0, 0, 0); }
        float ss = 0.f;
#pragma unroll
        for (int r = 0; r < 16; ++r) ss += o[r] * o[r];
        ss = xhalf_sum(ss);
        if (hi == 0) rs[db * 64 + 32 * ib + l31] = ss;
#pragma unroll
        for (int r4 = 0; r4 < 4; ++r4) *(LAS f32x4*)(stg + (32 * ib + l31) * STG_LD + 32 * db + 8 * r4 + 4 * hi) = (f32x4){o[4 * r4], o[4 * r4 + 1], o[4 * r4 + 2], o[4 * r4 + 3]};
        __syncthreads();
#pragma unroll
        for (int i = 0; i < 2; ++i) { const int e = tid + 512 * i, tk = e >> 4, cc = e & 15, dv0 = 8 * cc;
            const float rn = __builtin_amdgcn_rsqf(((rs[tk] + rs[64 + tk]) + (rs[128 + tk] + rs[192 + tk])) * (1.0f / 128.0f) + 1e-6f);
            const f32x4 o0 = *(LAS const f32x4*)(stg + tk * STG_LD + dv0), o1 = *(LAS const f32x4*)(stg + tk * STG_LD + dv0 + 4);
            const u32x4 gw = i ? gog1 : gog0; const f32x4 n0 = *(const f32x4*)(gon + dv0), n1 = *(const f32x4*)(gon + dv0 + 4);
            const float g[8] = {bflo(gw.x), bfhi(gw.x), bflo(gw.y), bfhi(gw.y), bflo(gw.z), bfhi(gw.z), bflo(gw.w), bfhi(gw.w)}; float y[8];
#pragma unroll
            for (int j = 0; j < 8; ++j) { const float ov = (j < 4 ? o0[j & 3] : o1[j & 3]), nv = (j < 4 ? n0[j & 3] : n1[j & 3]); y[j] = ov * rn * nv * (g[j] * __builtin_amdgcn_rcpf(1.0f + __builtin_amdgcn_exp2f(-g[j] * LOG2E))); }
            u32x4 w; w.x = cvtpk(y[0], y[1]); w.y = cvtpk(y[2], y[3]); w.z = cvtpk(y[4], y[5]); w.w = cvtpk(y[6], y[7]);
            *(u32x4*)(MIX + (size_t)(row0 + tk) * DM + 512 + 128 * hh + dv0) = w; }
        } }
}
}
#ifndef PROBE_MASK
#define PROBE_MASK 0
#endif
struct FastOrder : pg8::StaticOrder { int fx, fj, per, nig;
    __device__ __forceinline__ void init(int M, int N, int G_, int c_) { pg8::StaticOrder::init(M, N, G_, c_); fx = c_ & 7; fj = c_ >> 3; per = (N / pg8::BM) >> 1; nig = 8 * (N / pg8::BM); }
    __device__ __forceinline__ bool next(int i, pg8::Unit& u) const { if (i >= per) return false; const int l = 32 * i + fj, grp = (l >= nig) ? 1 : 0, r = l - (grp ? nig : 0); u.pm = 16 * fx + 8 * grp + (r & 7); u.pn = r >> 3; u.aux = 0; return true; } };
struct RepOrder : FastOrder { int reps;
    __device__ __forceinline__ void init2(int M, int N, int G_, int c_, int reps_) { init(M, N, G_, c_); reps = reps_; }
    __device__ __forceinline__ bool next(int i, pg8::Unit& u) const {
#if PROBE_MASK
        if (i >= per * reps) return false; const int rep = (i >= 7 * per) ? 7 : (i >= 6 * per) ? 6 : (i >= 5 * per) ? 5 : (i >= 4 * per) ? 4 : (i >= 3 * per) ? 3 : (i >= 2 * per) ? 2 : (i >= per) ? 1 : 0;
        const bool ok = FastOrder::next(i - rep * per, u); u.aux = rep; return ok;
#else
        return FastOrder::next(i, u);
#endif
    } };
struct SameOrder : pg8::StaticOrder { int n;
    __device__ __forceinline__ bool next(int i, pg8::Unit& u) const { if (i >= n) return false; u.pm = 0; u.pn = 0; return true; } };
__device__ __forceinline__ void team_table(const float* ssq, int nslots, int key, LAS float* rt) { const int t = threadIdx.x; rt[t] = pg8::rstd_row(ssq, (key + 8 * (t >> 8)) * 256 + (t & 255), nslots, 1.0f / 1024.0f); }
struct PreSeam { unsigned* ctl; int key; unsigned target; bool rel; XcdBarrier bar; int kind;
    int xg; unsigned xtarget; bool xrel;
    const float* ssqA; int nA; LAS float* rtA; const float* ssqB; int nB; LAS float* rtB;
    __device__ __forceinline__ void operator()() const {
        if (kind == 4) hook_wait(ctl, key, target, CW_TEAM); else if (kind == 5) hook_wait(ctl, xg, xtarget, CW_XG); else if (kind == 2) xcd_barrier(bar); }
    __device__ __forceinline__ void post() const {
        if (ssqA) team_table(ssqA, nA, key, rtA);
        if (ssqB) team_table(ssqB, nB, key, rtB);
        if (ssqA) { asm volatile("s_waitcnt lgkmcnt(0)" ::: "memory"); } } };
struct SliceOrder : FastOrder { int i0, i1;
    __device__ __forceinline__ bool next(int i, pg8::Unit& u) const { if (i0 + i >= i1) return false; return FastOrder::next(i0 + i, u); } };
#define NREP(k) ((((PROBE_MASK) >> (k)) & 1) ? 2 : 1)
constexpr int N_PHASES = 10;
__global__ void __launch_bounds__(NWAVES * 64, 2) hymba_fwd(Args args) {
    extern __shared__ __attribute__((aligned(16))) unsigned char lds_raw[];
    LAS unsigned char* lds = (LAS unsigned char*)lds_raw;
    const int tid = threadIdx.x, lane = tid & 63, wave = __builtin_amdgcn_readfirstlane(tid >> 6);
    const int G = gridDim.x, lo = args.ph_lo, hi = args.ph_hi;
    unsigned char* ws = args.ws;
    if (tid < 4) ((LAS unsigned*)(lds + LDSCTL_OFF))[tid] = 0u;
    __syncthreads();
    XcdBarrier bar = xcd_barrier_post((unsigned*)(ws + WS_CTL), (volatile LAS unsigned*)(lds + LDSCTL_OFF));
    unsigned* ctl = (unsigned*)(ws + WS_CTL); int team_key; { pg8::StaticOrder S0; S0.init(T_ROWS, DM, G, (int)blockIdx.x); pg8::Unit u0; u0.pm = 0; u0.pn = 0; u0.aux = 0; (void)S0.next(0, u0); team_key = u0.pm & 127; }
    if (tid == 0) (void)__hip_atomic_fetch_or(ctl + CW_TMASK + 64 * team_key, 1u << xb_xcc_id(), __ATOMIC_RELAXED, __HIP_MEMORY_SCOPE_AGENT);
    const int xg = (int)(blockIdx.x & 7);
    if (tid == 0) (void)__hip_atomic_fetch_or(ctl + CW_XGMASK + 64 * xg, 1u << xb_xcc_id(), __ATOMIC_RELAXED, __HIP_MEMORY_SCOPE_AGENT);
    unsigned team_epoch = 0, xg_epoch = 0; bool team_rel = true, xg_rel = true;
    bf16* XB = (bf16*)(ws + WS_XB); bf16* ACT = (bf16*)(ws + WS_ACT); bf16* MIX = (bf16*)(ws + WS_MIX); bf16* EMB = (bf16*)(ws + WS_EMB); bf16* PB = (bf16*)(ws + WS_PB);
    float* SSQ0 = (float*)(ws + WS_SSQ); float* SSQ1 = SSQ0 + (size_t)T_ROWS * 16; float* SSQ2 = SSQ1 + (size_t)T_ROWS * 16; float* SSQ3 = SSQ2 + (size_t)T_ROWS * 16; float* SSQ4 = SSQ3 + (size_t)T_ROWS * 16;
    const float* cosT = (const float*)(ws + WS_TAB); const float* sinT = cosT + SEQ * 32;
#ifndef PROBE_REPS
#define PROBE_REPS 2
#endif
#define REPS(k) for (int rep_ = 0; rep_ < (((PROBE_MASK) >> (k)) & 1 ? PROBE_REPS : 1); ++rep_)
#define IN(k) (lo <= (k) && (k) < hi)
#define SEAM(k) do { if (IN(k) && IN((k) + 1)) { xcd_barrier(bar); if ((PROBE_MASK >> 20) & 1) xcd_barrier(bar); } } while (0)
#define XSEAM(k) do { if (IN(k) && IN((k) + 1)) { xg_epoch += (unsigned)(G >> 3); team_barrier(ctl, xg, xg_epoch, xg_rel, CW_XG); } } while (0)
#define TSEAM(k) do { if (IN(k) && IN((k) + 1)) { team_epoch += 4u; team_barrier(ctl, team_key, team_epoch, team_rel); } } while (0)
    if (IN(0)) { phase_prologue(args, lds, wave, lane); asm volatile("s_waitcnt vmcnt(0)" ::: "memory"); __syncthreads();
        if (tid == 0) (void)__hip_atomic_fetch_add(ctl + CW_GRID, 1u, __ATOMIC_RELAXED, __HIP_MEMORY_SCOPE_AGENT);
        phase_prologue_team(args, team_key, wave, lane);
        if (tid == 0) { unsigned sp = 0; while (__hip_atomic_load(ctl + CW_GRID, __ATOMIC_RELAXED, __HIP_MEMORY_SCOPE_AGENT) < (unsigned)G) { __builtin_amdgcn_s_sleep(1); if (++sp > (1u << 22)) break; }
            __builtin_amdgcn_fence(__ATOMIC_ACQUIRE, "agent"); asm volatile("s_waitcnt vmcnt(0)" ::: "memory"); }
        __syncthreads(); }
    if (IN(0) && IN(1)) { team_rel = __builtin_popcount(__hip_atomic_load(ctl + CW_TMASK + 64 * team_key, __ATOMIC_RELAXED, __HIP_MEMORY_SCOPE_AGENT)) != 1;
        if ((PROBE_MASK >> 27) & 1) team_rel = true;
        xg_rel = ((PROBE_MASK >> 27) & 1) ? true : ((PROBE_MASK >> 21) & 1) ? false : __builtin_popcount(__hip_atomic_load(ctl + CW_XGMASK + 64 * xg, __ATOMIC_RELAXED, __HIP_MEMORY_SCOPE_AGENT)) != 1; }
    LAS float* rt = (LAS float*)(lds + LDSCTL_OFF + 64);
    const int k8 = team_key + 8;
    PreSeam pre{ctl, team_key, 0u, team_rel, bar, 0, xg, 0u, xg_rel, nullptr, 0, rt, nullptr, 0, rt + 1024};
#ifndef EMB_MODE
#define EMB_MODE 1
#endif
#define RUN_EMB(i0_, i1_) do { pg8::Gemm g_{PB, (const bf16*)(ws + W_PP), T_ROWS, DM, PLE}; SliceOrder S_; S_.init(T_ROWS, DM, G, (int)blockIdx.x); S_.i0 = (i0_); S_.i1 = (i1_); \
        pg8::EpiEmb E_{EMB, SSQ4}; pg8::gemm_phase<pg8::EpiEmb, SliceOrder, true, true>(lds, g_, S_, E_); } while (0)
    if (IN(1)) {
        if ((xg & 1) && EMB_MODE == 4) RUN_EMB(0, 2);
        if ((xg & 1) && EMB_MODE == 5) RUN_EMB(0, 1);
        { pg8::Gemm g{XB, (const bf16*)(ws + W_1GU), T_ROWS, NGU, DM}; RepOrder S; S.init2(T_ROWS, NGU, G, (int)blockIdx.x, NREP(1));
          team_epoch += 4u; group_arrive(ctl, team_key, team_rel, CW_TEAM); PreSeam p1 = pre; p1.kind = 4; p1.target = team_epoch; p1.ssqA = SSQ0; p1.nA = 1;
          pg8::EpiSwiGLU E{ACT, FF, rt, k8, -1, -1}; pg8::gemm_phase<pg8::EpiSwiGLU, RepOrder, true, true, PreSeam>(lds, g, S, E, p1); }
#if (PROBE_MASK >> 16) & 1
        { pg8::Gemm g{XB, (const bf16*)(ws + W_1GU), T_ROWS, NGU, DM}; RepOrder S; S.init2(T_ROWS, NGU, G, (int)blockIdx.x, 1);
          pg8::EpiNone E{}; pg8::gemm_phase<pg8::EpiNone, RepOrder, true, true>(lds, g, S, E); }
#endif
#if (PROBE_MASK >> 22) & 1
        { pg8::Gemm g{(const bf16*)(ws + WS_GS), (const bf16*)(ws + WS_GS), T_ROWS, NGU, DM}; RepOrder S; S.init2(T_ROWS, NGU, G, (int)blockIdx.x, 1);
          pg8::EpiNone E{}; pg8::gemm_phase<pg8::EpiNone, RepOrder, true, true>(lds, g, S, E); }
#endif
        if ((xg & 1) && EMB_MODE >= 1) group_arrive(ctl, team_key, team_rel, CW_TEAM);
        if ((xg & 1) && EMB_MODE != 4) RUN_EMB(EMB_MODE == 5 ? 1 : 0, 2);
    }
    if (IN(2)) { pg8::Gemm g{ACT, (const bf16*)(ws + W_1D), T_ROWS, DM, FF}; RepOrder S; S.init2(T_ROWS, DM, G, (int)blockIdx.x, NREP(2));
        team_epoch += 4u; if (!((xg & 1) && EMB_MODE >= 1)) group_arrive(ctl, team_key, team_rel, CW_TEAM); PreSeam p2 = pre; p2.kind = 4; p2.target = team_epoch;
        pg8::EpiResid E{XB, SSQ1, 0.5f}; pg8::gemm_phase<pg8::EpiResid, RepOrder, true, true, PreSeam>(lds, g, S, E, p2); }
    if (IN(3)) { pg8::Gemm g{XB, (const bf16*)(ws + W_IN), T_ROWS, NIN, DM}; RepOrder S; S.init2(T_ROWS, NIN, G, (int)blockIdx.x, NREP(3));
        team_epoch += 4u; group_arrive(ctl, team_key, team_rel, CW_TEAM); PreSeam p3 = pre; p3.kind = 4; p3.target = team_epoch; p3.ssqA = SSQ1; p3.nA = 16;
        pg8::EpiZ E{ACT, rt, k8, -1, -1, cosT, sinT, args.in[8], args.in[9]}; pg8::gemm_phase<pg8::EpiZ, RepOrder, true, true, PreSeam>(lds, g, S, E, p3); } XSEAM(3);
    if (IN(4)) { REPS(12) gla::passA(args, lds); xg_epoch += (unsigned)(G >> 3); group_arrive(ctl, xg, xg_rel, CW_XG); REPS(4) swa::attn_phase(ACT, MIX, args.in[10], lds); group_wait(ctl, xg, xg_epoch, CW_XG); }
    if (IN(5)) REPS(6) { gla::passB(args, lds); }
    if (IN(6)) { pg8::Gemm g{MIX, (const bf16*)(ws + W_OUT), T_ROWS, DM, DM}; RepOrder S; S.init2(T_ROWS, DM, G, (int)blockIdx.x, NREP(7));
        xg_epoch += (unsigned)(G >> 3); group_arrive(ctl, xg, xg_rel, CW_XG); PreSeam p6 = pre; p6.kind = 5; p6.xtarget = xg_epoch;
        pg8::EpiResid E{XB, SSQ2, 1.0f}; pg8::gemm_phase<pg8::EpiResid, RepOrder, true, true, PreSeam>(lds, g, S, E, p6); }
    if (IN(7)) { pg8::Gemm g{XB, (const bf16*)(ws + W_2GU), T_ROWS, NGU, DM}; RepOrder S; S.init2(T_ROWS, NGU, G, (int)blockIdx.x, 1);
        team_epoch += 4u; group_arrive(ctl, team_key, team_rel, CW_TEAM); PreSeam p7 = pre; p7.kind = 4; p7.target = team_epoch; p7.ssqA = SSQ2; p7.nA = 16;
        pg8::EpiSwiGLU E{ACT, FF, rt, k8, -1, -1};
#if (PROBE_MASK >> 26) & 1
        { SliceOrder S1; S1.init(T_ROWS, NGU, G, (int)blockIdx.x); S1.i0 = 0; S1.i1 = 6; pg8::gemm_phase<pg8::EpiSwiGLU, SliceOrder, true, true, PreSeam>(lds, g, S1, E, p7);
#if (PROBE_MASK >> 28) & 1
          PreSeam p7b = pre; p7b.kind = 0;
#elif (PROBE_MASK >> 29) & 1
          team_epoch += 4u; group_arrive(ctl, team_key, team_rel, CW_TEAM); PreSeam p7b = pre; p7b.kind = 4; p7b.target = team_epoch;
#else
          team_epoch += 4u; group_arrive(ctl, team_key, team_rel, CW_TEAM); PreSeam p7b = pre; p7b.kind = 4; p7b.target = team_epoch; p7b.ssqA = SSQ2; p7b.nA = 16;
#endif
          SliceOrder S2; S2.init(T_ROWS, NGU, G, (int)blockIdx.x); S2.i0 = 6; S2.i1 = 11; pg8::gemm_phase<pg8::EpiSwiGLU, SliceOrder, true, true, PreSeam>(lds, g, S2, E, p7b); }
#else
        pg8::gemm_phase<pg8::EpiSwiGLU, RepOrder, true, true, PreSeam>(lds, g, S, E, p7);
#endif
        }
    if (IN(8) && !(xg & 1) && EMB_MODE == 2) { group_arrive(ctl, team_key, team_rel, CW_TEAM);
        pg8::Gemm g{PB, (const bf16*)(ws + W_PP), T_ROWS, DM, PLE}; RepOrder S; S.init2(T_ROWS, DM, G, (int)blockIdx.x, NREP(11));
        pg8::EpiEmb E{EMB, SSQ4}; pg8::gemm_phase<pg8::EpiEmb, RepOrder, true, true>(lds, g, S, E); }
    if (IN(8)) { pg8::Gemm g{ACT, (const bf16*)(ws + W_2D), T_ROWS, DM, FF}; RepOrder S; S.init2(T_ROWS, DM, G, (int)blockIdx.x, NREP(8));
        team_epoch += 4u; if (!(!(xg & 1) && EMB_MODE == 2)) group_arrive(ctl, team_key, team_rel, CW_TEAM); PreSeam p8 = pre; p8.kind = 4; p8.target = team_epoch;
        pg8::EpiResid E{XB, SSQ3, 0.5f}; pg8::gemm_phase<pg8::EpiResid, RepOrder, true, true, PreSeam>(lds, g, S, E, p8); }
    if (IN(9) && !(xg & 1) && EMB_MODE == 3) { team_epoch += 4u; group_arrive(ctl, team_key, team_rel, CW_TEAM); }
    if (IN(9) && !(xg & 1) && EMB_MODE != 2) { pg8::Gemm g{PB, (const bf16*)(ws + W_PP), T_ROWS, DM, PLE}; RepOrder S; S.init2(T_ROWS, DM, G, (int)blockIdx.x, NREP(11));
        pg8::EpiEmb E{EMB, SSQ4}; pg8::gemm_phase<pg8::EpiEmb, RepOrder, true, true>(lds, g, S, E); }
    if (IN(9)) { pg8::Gemm g{XB, (const bf16*)(ws + W_PG), T_ROWS, DM, DM}; RepOrder S; S.init2(T_ROWS, DM, G, (int)blockIdx.x, NREP(9));
        team_epoch += 4u; group_arrive(ctl, team_key, team_rel, CW_TEAM); PreSeam p9 = pre; p9.kind = 4; p9.target = team_epoch; p9.ssqA = SSQ3; p9.nA = 16; p9.ssqB = SSQ4; p9.nB = 16;
        pg8::EpiPle E{args.out, XB, EMB, rt, rt + 1024, k8, -1, -1, args.in[22]}; pg8::gemm_phase<pg8::EpiPle, RepOrder, false, true, PreSeam>(lds, g, S, E, p9); }
#undef IN
#undef SEAM
}

#ifndef MK_N_LAUNCHES
#define MK_N_LAUNCHES 1
#endif
extern "C" void kernel_launch(void* const* d_in, const int* in_sizes, int n_in, void* d_out, int out_size, void* d_ws, size_t ws_size, hipStream_t stream) {
    static int grid = 0;
    if (grid == 0) {
        if (n_in != 23 || out_size != T_ROWS * DM || ws_size < WS_END) { fprintf(stderr, "kernel_launch: unexpected shapes: n_in %d out %d ws %zu (need %zu)\n", n_in, out_size, ws_size, (size_t)WS_END); grid = -1; return; }
        int dev = 0, cus = 0, per_cu = 0;
        if (hipGetDevice(&dev) != hipSuccess || hipDeviceGetAttribute(&cus, hipDeviceAttributeMultiprocessorCount, dev) != hipSuccess) { grid = -1; return; }
        if (hipFuncSetAttribute((const void*)hymba_fwd, hipFuncAttributeMaxDynamicSharedMemorySize, LDS_BYTES) != hipSuccess) { fprintf(stderr, "kernel_launch: hipFuncSetAttribute failed\n"); grid = -1; return; }
        if (hipOccupancyMaxActiveBlocksPerMultiprocessor(&per_cu, (const void*)hymba_fwd, NWAVES * 64, LDS_BYTES) != hipSuccess || per_cu < 1) { fprintf(stderr, "kernel_launch: occupancy query says %d\n", per_cu); per_cu = 1; }
        (void)hipGetLastError();
        if (cus != 256) { fprintf(stderr, "kernel_launch: built for a 256-CU device (teams of 4 and groups of 32 workgroups come from the 256-workgroup unit order); this one reports %d CUs; nothing launched\n", cus); grid = -1; return; }
        grid = cus;
        fprintf(stderr, "kernel_launch: cus %d per_cu %d grid %d ws %zu\n", cus, per_cu, grid, ws_size);
    }
    if (grid < 0) return;
    if (hipMemsetAsync((char*)d_ws + WS_CTL, 0, CTL_MEMSET_BYTES, stream) != hipSuccess) { fprintf(stderr, "kernel_launch: hipMemsetAsync failed\n"); return; }
    Args a{};
    for (int i = 0; i < 23; ++i) a.in[i] = (const float*)d_in[i];
    a.out = (float*)d_out; a.ws = (unsigned char*)d_ws;
    for (int li = 0; li < MK_N_LAUNCHES; ++li) {
        a.ph_lo = (MK_N_LAUNCHES == 1) ? 0 : li; a.ph_hi = (MK_N_LAUNCHES == 1) ? N_PHASES : li + 1;
        void* kargs[] = {&a};
        hipError_t e = hipLaunchCooperativeKernel((void*)hymba_fwd, dim3(grid), dim3(NWAVES * 64), kargs, LDS_BYTES, stream);
        if (e != hipSuccess) { fprintf(stderr, "kernel_launch: launch %d failed: %s\n", li, hipGetErrorString(e)); break; }
    }
}
```
